# Optimizing an MI355X kernel written in HIP

```python
import jax, jax.numpy as jnp
from jax import lax
import numpy as np

D_MODEL = 1024
BATCH = 2
SEQ = 8192
DEPTH = 2

HEAD_DIM = 64
BLOCK_Q = 128
ROPE_THETA = 10000.0
GRID_W = 64
EPS = 1e-6
D_FF = 2816
N_EVEN = (DEPTH + 1) // 2
N_ODD = DEPTH // 2
GMLP_GROUPS = 8
GMLP_GROUP_DIM = 64
GMLP_CHUNK = 128
GMLP_WIDTH = GMLP_GROUPS * GMLP_GROUP_DIM
DIFF_HEADS = 4
DIFF_D = 64
DIFF_V = 2 * DIFF_D
MLA_HEADS = 8
MLA_Q_RANK = 256
MLA_KV_RANK = 128
MLA_NOPE = 64
MLA_ROPE = 32
MLA_V = 64
GQA_Q_HEADS = 8
GQA_KV_HEADS = 2
GQA_GROUP = GQA_Q_HEADS // GQA_KV_HEADS
GQA_DIM = 64

EVEN_IN = 2 * GMLP_WIDTH + 2 * DIFF_HEADS * 2 * DIFF_D + DIFF_HEADS * DIFF_V
EVEN_OUT = GMLP_WIDTH + DIFF_HEADS * DIFF_V
ODD_IN = (MLA_Q_RANK + MLA_KV_RANK + MLA_ROPE
          + GQA_Q_HEADS * GQA_DIM + 2 * GQA_KV_HEADS * GQA_DIM)
ODD_OUT = MLA_HEADS * MLA_V + GQA_Q_HEADS * GQA_DIM

kernel_name = "hybrid_gmlp_diffattn_mla_axialgqa_macaron"


def rmsnorm(x, g):
    xf = x.astype(jnp.float32)
    y = xf * lax.rsqrt(jnp.mean(xf * xf, axis=-1, keepdims=True) + EPS)
    return (y * g.astype(jnp.float32)).astype(x.dtype)


def rope_angles(pos, dim):
    inv = ROPE_THETA ** (-jnp.arange(0, dim, 2, dtype=jnp.float32) / dim)
    ang = pos.astype(jnp.float32)[:, None] * inv[None, :]
    return jnp.cos(ang), jnp.sin(ang)


def apply_rope(x, cos, sin):
    shape = (cos.shape[0],) + (1,) * (x.ndim - 3) + (cos.shape[-1],)
    c = cos.reshape(shape)
    s = sin.reshape(shape)
    xf = x.astype(jnp.float32)
    x1, x2 = jnp.split(xf, 2, axis=-1)
    return jnp.concatenate([x1 * c - x2 * s, x1 * s + x2 * c], axis=-1).astype(x.dtype)


def axial_rope(x, row_cs, col_cs):
    half = x.shape[-1] // 2
    return jnp.concatenate([apply_rope(x[..., :half], *row_cs),
                            apply_rope(x[..., half:], *col_cs)], axis=-1)


def to_blocks(t):
    b, s = t.shape[:2]
    t = t.reshape((b, s // BLOCK_Q, BLOCK_Q) + t.shape[2:])
    return jnp.moveaxis(t, 1, 0)


def from_blocks(t):
    t = jnp.moveaxis(t, 0, 1)
    return t.reshape((t.shape[0], t.shape[1] * t.shape[2]) + t.shape[3:])


def gqa_attention(q, k, v):
    scale = q.shape[-1] ** -0.5

    def blk(qb):
        s = jnp.einsum('bqhgd,bshd->bhgqs', qb, k).astype(jnp.float32) * scale
        p = jax.nn.softmax(s, axis=-1).astype(v.dtype)
        return jnp.einsum('bhgqs,bshe->bqhge', p, v)

    return from_blocks(lax.map(blk, to_blocks(q)))


def swiglu(h, w_gu, w_down):
    g, u = jnp.split(h @ w_gu, 2, axis=-1)
    return (jax.nn.silu(g) * u) @ w_down


def mixer_gmlp(u, v, sgu_norm, w_s, b_s):
    b, s, _ = v.shape
    vc = v.reshape(b, s // GMLP_CHUNK, GMLP_CHUNK, GMLP_GROUPS, GMLP_GROUP_DIM)
    vc = rmsnorm(vc, sgu_norm)
    mixed = jnp.einsum('gij,bcjgd->bcigd', w_s, vc) + b_s.T[:, :, None]
    return u * mixed.reshape(b, s, GMLP_WIDTH)


def mixer_diff(q, k, v, q_norm, k_norm, lam_q1, lam_k1, lam_q2, lam_k2,
               sub_norm, lam_init, cos, sin):
    b, s = q.shape[:2]
    q = apply_rope(rmsnorm(q, q_norm), cos, sin)
    k = apply_rope(rmsnorm(k, k_norm), cos, sin)
    f32 = jnp.float32
    lam = (jnp.exp(jnp.sum(lam_q1.astype(f32) * lam_k1.astype(f32)))
           - jnp.exp(jnp.sum(lam_q2.astype(f32) * lam_k2.astype(f32))) + lam_init)
    scale = DIFF_D ** -0.5

    def blk(qb):
        sc = jnp.einsum('bqhmd,bshmd->bhmqs', qb, k).astype(f32) * scale
        p = jax.nn.softmax(sc, axis=-1)
        w = (p[:, :, 0] - lam * p[:, :, 1]).astype(v.dtype)
        return jnp.einsum('bhqs,bshe->bqhe', w, v)

    o = from_blocks(lax.map(blk, to_blocks(q)))
    o = rmsnorm(o, sub_norm) * (1.0 - lam_init)
    return o.reshape(b, s, DIFF_HEADS * DIFF_V)


def setup_inputs(seed: int = 0) -> dict:
    key = jax.random.key(seed)
    ks = iter(jax.random.split(key, 40))
    f32 = jnp.float32

    def w(shape, fan_in):
        return jax.random.normal(next(ks), shape, f32) * (fan_in ** -0.5)

    def gain(shape):
        return 1.0 + 0.02 * jax.random.normal(next(ks), shape, f32)

    def small(shape, scale):
        return scale * jax.random.normal(next(ks), shape, f32)

    d = D_MODEL
    return {
        "x": jax.random.normal(next(ks), (BATCH, SEQ, d), f32),
        "ffn1_norm": gain((DEPTH, d)),
        "ffn1_w_gu": w((DEPTH, d, 2 * D_FF), d),
        "ffn1_w_down": w((DEPTH, D_FF, d), D_FF),
        "ffn2_norm": gain((DEPTH, d)),
        "ffn2_w_gu": w((DEPTH, d, 2 * D_FF), d),
        "ffn2_w_down": w((DEPTH, D_FF, d), D_FF),
        "ev_norm": gain((N_EVEN, d)),
        "ev_w_in": w((N_EVEN, d, EVEN_IN), d),
        "ev_sgu_norm": gain((N_EVEN, GMLP_GROUPS, GMLP_GROUP_DIM)),
        "ev_w_s": w((N_EVEN, GMLP_GROUPS, GMLP_CHUNK, GMLP_CHUNK), GMLP_CHUNK),
        "ev_b_s": gain((N_EVEN, GMLP_GROUPS, GMLP_CHUNK)),
        "ev_q_norm": gain((N_EVEN, DIFF_D)),
        "ev_k_norm": gain((N_EVEN, DIFF_D)),
        "ev_lam_q1": small((N_EVEN, DIFF_D), 0.1),
        "ev_lam_k1": small((N_EVEN, DIFF_D), 0.1),
        "ev_lam_q2": small((N_EVEN, DIFF_D), 0.1),
        "ev_lam_k2": small((N_EVEN, DIFF_D), 0.1),
        "ev_sub_norm": gain((N_EVEN, DIFF_V)),
        "ev_w_out": w((N_EVEN, EVEN_OUT, d), EVEN_OUT),
        "od_norm": gain((N_ODD, d)),
        "od_w_in": w((N_ODD, d, ODD_IN), d),
        "od_cq_norm": gain((N_ODD, MLA_Q_RANK)),
        "od_ckv_norm": gain((N_ODD, MLA_KV_RANK)),
        "od_w_uq": w((N_ODD, MLA_Q_RANK, MLA_HEADS * (MLA_NOPE + MLA_ROPE)), MLA_Q_RANK),
        "od_w_ukv": w((N_ODD, MLA_KV_RANK, MLA_HEADS * (MLA_NOPE + MLA_V)), MLA_KV_RANK),
        "od_mla_q_norm": gain((N_ODD, MLA_NOPE + MLA_ROPE)),
        "od_mla_k_norm": gain((N_ODD, MLA_NOPE + MLA_ROPE)),
        "od_gqa_q_norm": gain((N_ODD, GQA_DIM)),
        "od_gqa_k_norm": gain((N_ODD, GQA_DIM)),
        "od_w_out": w((N_ODD, ODD_OUT, d), ODD_OUT),
    }


def reference(x, ffn1_norm, ffn1_w_gu, ffn1_w_down, ffn2_norm, ffn2_w_gu, ffn2_w_down,
              ev_norm, ev_w_in, ev_sgu_norm, ev_w_s, ev_b_s, ev_q_norm, ev_k_norm,
              ev_lam_q1, ev_lam_k1, ev_lam_q2, ev_lam_k2, ev_sub_norm, ev_w_out,
              od_norm, od_w_in, od_cq_norm, od_ckv_norm, od_w_uq, od_w_ukv,
              od_mla_q_norm, od_mla_k_norm, od_gqa_q_norm, od_gqa_k_norm, od_w_out):
    b, s, _ = x.shape
    rows = s // GRID_W
    pos = jnp.arange(s, dtype=jnp.int32)
    row_idx = jnp.repeat(jnp.arange(rows, dtype=jnp.int32), GRID_W)
    col_idx = jnp.tile(jnp.arange(GRID_W, dtype=jnp.int32), rows)
    cs_full = rope_angles(pos, DIFF_D)
    cs_mla = rope_angles(pos, MLA_ROPE)
    cs_row = rope_angles(row_idx, GQA_DIM // 2)
    cs_col = rope_angles(col_idx, GQA_DIM // 2)

    for l in range(DEPTH):
        x = x + 0.5 * swiglu(rmsnorm(x, ffn1_norm[l]), ffn1_w_gu[l], ffn1_w_down[l])
        if l % 2 == 0:
            i = l // 2
            proj = rmsnorm(x, ev_norm[i]) @ ev_w_in[i]
            a_uv, bq, bk, bv = jnp.split(
                proj, [2 * GMLP_WIDTH, 2 * GMLP_WIDTH + 2 * DIFF_HEADS * DIFF_D,
                       2 * GMLP_WIDTH + 4 * DIFF_HEADS * DIFF_D], axis=-1)
            u, v = jnp.split(jax.nn.gelu(a_uv), 2, axis=-1)
            out_a = mixer_gmlp(u, v, ev_sgu_norm[i], ev_w_s[i], ev_b_s[i])
            lam_init = 0.8 - 0.6 * float(np.exp(-0.3 * l))
            out_b = mixer_diff(
                bq.reshape(b, s, DIFF_HEADS, 2, DIFF_D),
                bk.reshape(b, s, DIFF_HEADS, 2, DIFF_D),
                bv.reshape(b, s, DIFF_HEADS, DIFF_V),
                ev_q_norm[i], ev_k_norm[i], ev_lam_q1[i], ev_lam_k1[i],
                ev_lam_q2[i], ev_lam_k2[i], ev_sub_norm[i], lam_init, *cs_full)
            mix = jnp.concatenate([out_a, out_b], axis=-1) @ ev_w_out[i]
        else:
            i = l // 2
            proj = rmsnorm(x, od_norm[i]) @ od_w_in[i]
            o1 = MLA_Q_RANK
            o2 = o1 + MLA_KV_RANK
            o3 = o2 + MLA_ROPE
            o4 = o3 + GQA_Q_HEADS * GQA_DIM
            o5 = o4 + GQA_KV_HEADS * GQA_DIM
            c_q, c_kv, k_pe, gq, gk, gv = jnp.split(proj, [o1, o2, o3, o4, o5], axis=-1)
            q = (rmsnorm(c_q, od_cq_norm[i]) @ od_w_uq[i]).reshape(
                b, s, MLA_HEADS, MLA_NOPE + MLA_ROPE)
            kv = (rmsnorm(c_kv, od_ckv_norm[i]) @ od_w_ukv[i]).reshape(
                b, s, MLA_HEADS, MLA_NOPE + MLA_V)
            k_nope, v_c = jnp.split(kv, [MLA_NOPE], axis=-1)
            k = jnp.concatenate(
                [k_nope, jnp.broadcast_to(k_pe[:, :, None, :], (b, s, MLA_HEADS, MLA_ROPE))],
                axis=-1)
            q = rmsnorm(q, od_mla_q_norm[i])
            k = rmsnorm(k, od_mla_k_norm[i])
            q = jnp.concatenate([q[..., :MLA_NOPE], apply_rope(q[..., MLA_NOPE:], *cs_mla)], axis=-1)
            k = jnp.concatenate([k[..., :MLA_NOPE], apply_rope(k[..., MLA_NOPE:], *cs_mla)], axis=-1)
            out_c = gqa_attention(q[:, :, :, None, :], k, v_c).reshape(b, s, MLA_HEADS * MLA_V)
            qd = rmsnorm(gq.reshape(b, s, GQA_KV_HEADS, GQA_GROUP, GQA_DIM), od_gqa_q_norm[i])
            kd = rmsnorm(gk.reshape(b, s, GQA_KV_HEADS, GQA_DIM), od_gqa_k_norm[i])
            vd = gv.reshape(b, s, GQA_KV_HEADS, GQA_DIM)
            qd = axial_rope(qd, cs_row, cs_col)
            kd = axial_rope(kd, cs_row, cs_col)
            out_d = gqa_attention(qd, kd, vd).reshape(b, s, GQA_Q_HEADS * GQA_DIM)
            mix = jnp.concatenate([out_c, out_d], axis=-1) @ od_w_out[i]
        x = x + mix
        x = x + 0.5 * swiglu(rmsnorm(x, ffn2_norm[l]), ffn2_w_gu[l], ffn2_w_down[l])
    return x
```

```cpp
#include <hip/hip_runtime.h>
#include <hip/hip_cooperative_groups.h>
#include <stdint.h>
#include <stdio.h>
#include <type_traits>
namespace cg = cooperative_groups;

typedef unsigned short bf16_t;
typedef __attribute__((ext_vector_type(8))) short bf16x8;
typedef __attribute__((ext_vector_type(16))) float f32x16;
typedef __attribute__((ext_vector_type(4))) float f32x4;
typedef __attribute__((ext_vector_type(4))) unsigned u32x4;
typedef __attribute__((ext_vector_type(2))) unsigned u32x2;
typedef float f32x2_t __attribute__((ext_vector_type(2)));
typedef __bf16 bf16x2_t __attribute__((ext_vector_type(2)));

constexpr int T = 16384, S = 8192, DM = 1024, DFF = 2816;
constexpr float EPS = 1e-6f;
constexpr float LOG2E = 1.4426950408889634f;

constexpr size_t O_CTL = 0;
constexpr size_t O_COS64 = 16384;
constexpr size_t O_SIN64 = O_COS64 + (size_t)8192 * 32 * 4;
constexpr size_t O_COS32 = O_SIN64 + (size_t)8192 * 32 * 4;
constexpr size_t O_SIN32 = O_COS32 + (size_t)8192 * 16 * 4;
constexpr size_t O_SSQ = O_SIN32 + (size_t)8192 * 16 * 4;
constexpr size_t O_SSQ2 = O_SSQ + (size_t)T * 16 * 4;
constexpr size_t O_KPE = O_SSQ2 + (size_t)T * 8 * 4;
constexpr size_t O_WGU = O_KPE + (size_t)T * 32 * 4;
constexpr size_t SZ_WGU = (size_t)5632 * 1024 * 2;
constexpr size_t O_WDN = O_WGU + 4 * SZ_WGU;
constexpr size_t SZ_WDN = (size_t)1024 * 2816 * 2;
constexpr size_t O_WEVIN = O_WDN + 4 * SZ_WDN;
constexpr size_t O_WEVOUT = O_WEVIN + (size_t)2560 * 1024 * 2;
constexpr size_t O_WODIN = O_WEVOUT + (size_t)1024 * 1024 * 2;
constexpr size_t O_WUQ = O_WODIN + (size_t)1280 * 1024 * 2;
constexpr size_t O_WUKV = O_WUQ + (size_t)1024 * 256 * 2;
constexpr size_t O_WODOUT = O_WUKV + (size_t)1024 * 128 * 2;
constexpr size_t O_WSS = O_WODOUT + (size_t)1024 * 1024 * 2;
constexpr size_t O_XB = O_WSS + (size_t)8 * 128 * 128 * 2;
constexpr size_t O_X16 = O_XB + (size_t)T * 1024 * 2;
constexpr size_t O_BIG = O_X16 + (size_t)T * 1024 * 2;
constexpr size_t O_H = O_BIG;
constexpr size_t O_M1 = O_BIG;
constexpr size_t O_U = O_M1;
constexpr size_t O_VT = O_U + (size_t)T * 512 * 2;
constexpr size_t O_QB = O_VT + (size_t)T * 512 * 2;
constexpr size_t O_KB = O_QB + (size_t)T * 512 * 2;
constexpr size_t O_VTB = O_KB + (size_t)T * 512 * 2;
constexpr size_t O_EV_END = O_VTB + (size_t)T * 512 * 2;
constexpr size_t O_CQ = O_M1;
constexpr size_t O_CKV = O_CQ + (size_t)T * 256 * 2;
constexpr size_t O_QC = O_CKV + (size_t)T * 128 * 2;
constexpr size_t O_KC = O_QC + (size_t)T * 8 * 96 * 2;
constexpr size_t O_VTC = O_KC + (size_t)T * 8 * 96 * 2;
constexpr size_t O_QD = O_VTC + (size_t)T * 512 * 2;
constexpr size_t O_KD = O_QD + (size_t)T * 512 * 2;
constexpr size_t O_VTD = O_KD + (size_t)T * 128 * 2;
constexpr size_t O_OD_END = O_VTD + (size_t)T * 128 * 2;
constexpr size_t O_H_END = O_H + (size_t)T * DFF * 2;
static_assert(O_OD_END <= ((size_t)256 << 20) && O_EV_END <= ((size_t)256 << 20) && O_H_END <= ((size_t)256 << 20), "ws map");

struct Params {
  const float* x; const float* ffn1_norm; const float* ffn1_w_gu; const float* ffn1_w_down;
  const float* ffn2_norm; const float* ffn2_w_gu; const float* ffn2_w_down;
  const float* ev_norm; const float* ev_w_in; const float* ev_sgu_norm; const float* ev_w_s; const float* ev_b_s;
  const float* ev_q_norm; const float* ev_k_norm; const float* ev_lam_q1; const float* ev_lam_k1; const float* ev_lam_q2; const float* ev_lam_k2;
  const float* ev_sub_norm; const float* ev_w_out;
  const float* od_norm; const float* od_w_in; const float* od_cq_norm; const float* od_ckv_norm; const float* od_w_uq; const float* od_w_ukv;
  const float* od_mla_q_norm; const float* od_mla_k_norm; const float* od_gqa_q_norm; const float* od_gqa_k_norm; const float* od_w_out;
  float* out; char* ws; int flags; int pad;
};

__device__ __forceinline__ unsigned pk2(float lo, float hi) { f32x2_t v = {lo, hi}; bf16x2_t b = __builtin_convertvector(v, bf16x2_t); return __builtin_bit_cast(unsigned, b); }
__device__ __forceinline__ bf16_t f2bf(float f) { return (bf16_t)(pk2(f, 0.f) & 0xffffu); }
__device__ __forceinline__ float fexp2(float x) { return __builtin_amdgcn_exp2f(x); }
__device__ __forceinline__ float frcp(float x) { return __builtin_amdgcn_rcpf(x); }
__device__ __forceinline__ float sigm(float x) { return frcp(1.f + fexp2(-LOG2E * x)); }
__device__ __forceinline__ float gelu_tanh(float x) { const float y = 0.7978845608028654f * (x + 0.044715f * x * x * x); return x * sigm(2.f * y); }
__device__ __forceinline__ float bf2f(unsigned short b) { return __builtin_bit_cast(float, (unsigned)b << 16); }
__device__ __forceinline__ int swz23(int r) { return (r & ~12) | ((r & 4) << 1) | ((r & 8) >> 1); }
__device__ __forceinline__ float rstd16(const float* __restrict__ ssq, int tok) {
  const f32x4* p = (const f32x4*)(ssq + (size_t)tok * 16);
  const f32x4 a = p[0], b = p[1], c = p[2], d = p[3];
  const float s = ((a[0] + a[1]) + (a[2] + a[3])) + ((b[0] + b[1]) + (b[2] + b[3])) + ((c[0] + c[1]) + (c[2] + c[3])) + ((d[0] + d[1]) + (d[2] + d[3]));
  return rsqrtf(s * (1.f / 1024.f) + EPS);
}
#define MFMA(a, b, c) __builtin_amdgcn_mfma_f32_32x32x16_bf16((a), (b), (c), 0, 0, 0)

namespace pg8 {
#define PG8_LAS __attribute__((address_space(3)))
typedef unsigned short bf16_t;
typedef short bf16x8 __attribute__((ext_vector_type(8)));
typedef float f32x4 __attribute__((ext_vector_type(4)));
typedef unsigned u32x4 __attribute__((ext_vector_type(4)));
constexpr int BM = 256, BK = 64, HALF = 128, HTB = HALF * BK * 2  , STAGE_BYTES = 8 * HTB, NXCD = 8, WGM = 8;

__host__ __device__ __forceinline__ int lds_byte(int r, int c) { const int st = (r >> 4) * 2 + (c >> 5), rr = r & 15, cc = c & 31, ob = rr * 64 + cc * 2; return st * 1024 + (ob ^ (((ob >> 9) & 1) << 5)); }
__host__ __device__ __forceinline__ void stage_rc(int b, int& R, int& C) { const int st = b / 1024, sb = b % 1024, swz = sb ^ (((sb >> 9) & 1) << 5); R = (st >> 1) * 16 + swz / 64; C = (st & 1) * 32 + (swz % 64) / 2; }
__host__ __device__ __forceinline__ int perm32(int rho) { const int n = rho >> 4, i = rho & 15; return 8 * (i >> 2) + 4 * n + (i & 3); }

struct Unit { int pm, pn; };
struct Gemm { const bf16_t* A; const bf16_t* Bt; int M, N, K; };

struct StaticOrder {
    int nM, nN, nwg, G, c;
    __host__ __device__ void init(int M, int N, int G_, int c_) { nM = M / BM; nN = N / BM; nwg = nM * nN; G = G_; c = c_; }
    __host__ __device__ bool next(int i, Unit& u) const {
        const long L = (long)i * G + c; if (L >= nwg) return false;
        int wgid = (int)L; { const int q = nwg / NXCD, r = nwg % NXCD, xcd = wgid % NXCD, off = wgid / NXCD; wgid = (xcd < r ? xcd * (q + 1) : r * (q + 1) + (xcd - r) * q) + off; }
        const int nig = WGM * nN, gid = wgid / nig, fm = gid * WGM, gsz = (nM - fm) < WGM ? (nM - fm) : WGM;
        u.pm = fm + ((wgid % nig) % gsz); u.pn = (wgid % nig) / gsz; return true;
    }
    __device__ __forceinline__ void a_ready(const Unit&) const {}
    __device__ __forceinline__ void done(const Unit&) const {}
};
__device__ __forceinline__ unsigned cvt_pk_bf16(float lo, float hi) { unsigned r; asm volatile("v_cvt_pk_bf16_f32 %0, %1, %2" : "=v"(r) : "v"(lo), "v"(hi)); return r; }
typedef _Float16 f16x8 __attribute__((ext_vector_type(8)));
template <bool F16> __device__ __forceinline__ f32x4 mma16(bf16x8 b, bf16x8 a, f32x4 c) {
    if constexpr (F16) return __builtin_amdgcn_mfma_f32_16x16x32_f16(__builtin_bit_cast(f16x8, b), __builtin_bit_cast(f16x8, a), c, 0, 0, 0);
    else return __builtin_amdgcn_mfma_f32_16x16x32_bf16(b, a, c, 0, 0, 0);
}
template <class Epi, class Sched, bool ALIGN_EPI = false, bool SP2 = false, bool F16 = false, bool TOKPERM = false>
__device__ __forceinline__ void gemm_phase(PG8_LAS unsigned char* lds, const Gemm g, const Sched& S, const Epi& E) {
    int tid_ = threadIdx.x; asm volatile("" : "+v"(tid_));
    const int tid = tid_, wid = __builtin_amdgcn_readfirstlane(tid >> 6), lane = tid & 63, wr = wid >> 2, wc = wid & 3, fr = lane & 15, fq = lane >> 4;
    const int K = g.K, nt = K / BK;
    unsigned voffA[2], voffB[2];
#pragma unroll
    for (int i = 0; i < 2; ++i) { int R, C; stage_rc(tid * 16 + i * 8192, R, C); const int Rb = Epi::PERM ? ((R & ~31) + perm32(R & 31)) : R;
        const int Ra = TOKPERM ? ((R & ~63) + 4 * (R & 15) + ((R >> 4) & 3)) : R;
        voffA[i] = (unsigned)(Ra * K + C) * 2u; voffB[i] = (unsigned)(Rb * K + C) * 2u; }
    const size_t kstep = (size_t)(BK * 2);
    const size_t hstep = (size_t)HALF * K * 2;
    const size_t tstep = 2 * hstep;
    const unsigned ldsw = (unsigned)wid * 1024u;
    const int aoff = lds_byte(wr * 64 + fr, fq * 8), boff = lds_byte(wc * 32 + fr, fq * 8);
#define PG8_SA(b, h) (((b) * 2 + (h)) * HTB)
#define PG8_SB(b, h) ((4 + (b) * 2 + (h)) * HTB)
#define PG8_STAGE(bufoff, gbase, voff) do { _Pragma("unroll") for (int _i = 0; _i < 2; ++_i) \
        __builtin_amdgcn_global_load_lds((const unsigned*)((const char*)(gbase) + (voff)[_i]), (PG8_LAS unsigned*)(lds + (bufoff) + ldsw + _i * 8192), 16, 0, 0); } while (0)
#define PG8_LDA(dst, b, h) do { _Pragma("unroll") for (int m = 0; m < 4; ++m) _Pragma("unroll") for (int k = 0; k < 2; ++k) dst[m][k] = *(const PG8_LAS bf16x8*)(lds + PG8_SA(b, h) + aoff + m * 2048 + k * 1024); } while (0)
#define PG8_LDB(dst, b, h) do { _Pragma("unroll") for (int n = 0; n < 2; ++n) _Pragma("unroll") for (int k = 0; k < 2; ++k) dst[n][k] = *(const PG8_LAS bf16x8*)(lds + PG8_SB(b, h) + boff + n * 2048 + k * 1024); } while (0)
#define PG8_MMA(ai, bj, At, Bt) do { __builtin_amdgcn_s_setprio(1); _Pragma("unroll") for (int m = 0; m < 4; ++m) _Pragma("unroll") for (int n = 0; n < 2; ++n) _Pragma("unroll") for (int k = 0; k < 2; ++k) \
        acc[ai][bj][m][n] = mma16<F16>(Bt[n][k], At[m][k], acc[ai][bj][m][n]); __builtin_amdgcn_s_setprio(0); } while (0)
#define PG8_WAIT_V(n) asm volatile("s_waitcnt vmcnt(" #n ")" ::: "memory")
#define PG8_WAIT_L(n) asm volatile("s_waitcnt lgkmcnt(" #n ")" ::: "memory")
#define PG8_BAR __builtin_amdgcn_s_barrier()
#define PG8_SCHED __builtin_amdgcn_sched_barrier(0)
    Unit cur, nxt; int ui = 0;
    if (!S.next(0, cur)) return;
    f32x4 acc[2][2][4][2];
#pragma unroll
    for (int a = 0; a < 2; ++a)
#pragma unroll
        for (int b = 0; b < 2; ++b)
#pragma unroll
            for (int m = 0; m < 4; ++m)
#pragma unroll
                for (int n = 0; n < 2; ++n) acc[a][b][m][n] = (f32x4){0.f, 0.f, 0.f, 0.f};
    bf16x8 At[4][2], B0[2][2], B1[2][2];
    const char* cA = (const char*)g.A + (size_t)cur.pm * tstep; const char* cB = (const char*)g.Bt + (size_t)cur.pn * tstep;
    S.a_ready(cur);
    if constexpr (SP2) {
        PG8_STAGE(PG8_SB(0, 0), cB, voffB); PG8_STAGE(PG8_SB(0, 1), cB + hstep, voffB); PG8_STAGE(PG8_SA(0, 0), cA, voffA); PG8_STAGE(PG8_SA(0, 1), cA + hstep, voffA);
        if (wr == 1) PG8_BAR;
        PG8_WAIT_V(2); PG8_BAR;
        PG8_STAGE(PG8_SB(1, 0), cB + kstep, voffB); PG8_STAGE(PG8_SA(1, 0), cA + kstep, voffA); PG8_STAGE(PG8_SB(1, 1), cB + hstep + kstep, voffB);
        PG8_WAIT_V(6); PG8_BAR;
    } else {
        PG8_STAGE(PG8_SB(0, 0), cB, voffB); PG8_STAGE(PG8_SA(0, 0), cA, voffA); PG8_STAGE(PG8_SB(0, 1), cB + hstep, voffB); PG8_STAGE(PG8_SA(0, 1), cA + hstep, voffA);
        if (wr == 1) PG8_BAR;
        PG8_WAIT_V(4); PG8_BAR;
        PG8_STAGE(PG8_SB(1, 0), cB + kstep, voffB); PG8_STAGE(PG8_SA(1, 0), cA + kstep, voffA); PG8_STAGE(PG8_SB(1, 1), cB + hstep + kstep, voffB);
        PG8_WAIT_V(6); PG8_BAR;
    }
    for (;;) {
        const bool has_next = S.next(ui + 1, nxt);
        const char* nA = has_next ? (const char*)g.A + (size_t)nxt.pm * tstep : cA; const char* nB = has_next ? (const char*)g.Bt + (size_t)nxt.pn * tstep : cB;
        for (int t = 0; t < nt; t += 2) {
            const bool last = (t == nt - 2);
            const char* a1 = cA + (size_t)(t + 1) * kstep;
            const char* a2 = last ? nA : cA + (size_t)(t + 2) * kstep; const char* b2 = last ? nB : cB + (size_t)(t + 2) * kstep;
            const char* a3 = a2 + kstep; const char* b3 = b2 + kstep;
            if (last && has_next) S.a_ready(nxt);
            if constexpr (SP2) {
            PG8_LDB(B0, 0, 0); PG8_LDB(B1, 0, 1); PG8_SCHED; PG8_LDA(At, 0, 0); PG8_STAGE(PG8_SA(1, 1), a1 + hstep, voffA);
            PG8_WAIT_V(8); PG8_WAIT_L(0); PG8_BAR; PG8_MMA(0, 0, At, B0); PG8_MMA(0, 1, At, B1); PG8_BAR; PG8_SCHED;
            PG8_LDA(At, 0, 1); PG8_STAGE(PG8_SB(0, 0), b2, voffB); PG8_STAGE(PG8_SB(0, 1), b2 + hstep, voffB); PG8_STAGE(PG8_SA(0, 0), a2, voffA);
            PG8_WAIT_V(8); PG8_WAIT_L(0); PG8_BAR; PG8_MMA(1, 0, At, B0); PG8_MMA(1, 1, At, B1); PG8_BAR; PG8_SCHED;
            PG8_LDB(B0, 1, 0); PG8_LDB(B1, 1, 1); PG8_SCHED; PG8_LDA(At, 1, 0); PG8_STAGE(PG8_SA(0, 1), a2 + hstep, voffA);
            PG8_WAIT_V(8); PG8_WAIT_L(0); PG8_BAR; PG8_MMA(0, 0, At, B0); PG8_MMA(0, 1, At, B1); PG8_BAR; PG8_SCHED;
            PG8_LDA(At, 1, 1); PG8_STAGE(PG8_SB(1, 0), b3, voffB); PG8_STAGE(PG8_SB(1, 1), b3 + hstep, voffB); PG8_STAGE(PG8_SA(1, 0), a3, voffA);
            PG8_WAIT_V(8); PG8_WAIT_L(0); PG8_BAR; PG8_MMA(1, 0, At, B0); PG8_MMA(1, 1, At, B1); PG8_BAR; PG8_SCHED;
            } else {
            PG8_LDB(B0, 0, 0); PG8_SCHED; PG8_LDA(At, 0, 0); PG8_STAGE(PG8_SA(1, 1), a1 + hstep, voffA);
            PG8_WAIT_L(8); PG8_BAR; PG8_WAIT_L(0); PG8_MMA(0, 0, At, B0); PG8_BAR; PG8_SCHED;
            PG8_LDB(B1, 0, 1); PG8_STAGE(PG8_SB(0, 0), b2, voffB);
            PG8_BAR; PG8_WAIT_L(0); PG8_MMA(0, 1, At, B1); PG8_BAR;
            PG8_LDA(At, 0, 1); PG8_STAGE(PG8_SA(0, 0), a2, voffA);
            PG8_BAR; PG8_WAIT_L(0); PG8_MMA(1, 0, At, B0); PG8_BAR; PG8_SCHED;
            PG8_STAGE(PG8_SB(0, 1), b2 + hstep, voffB);
            PG8_WAIT_V(6); PG8_BAR; PG8_MMA(1, 1, At, B1); PG8_BAR;
            PG8_LDB(B0, 1, 0); PG8_SCHED; PG8_LDA(At, 1, 0); PG8_STAGE(PG8_SA(0, 1), a2 + hstep, voffA);
            PG8_WAIT_L(8); PG8_BAR; PG8_WAIT_L(0); PG8_MMA(0, 0, At, B0); PG8_BAR; PG8_SCHED;
            PG8_LDB(B1, 1, 1); PG8_STAGE(PG8_SB(1, 0), b3, voffB);
            PG8_BAR; PG8_WAIT_L(0); PG8_MMA(0, 1, At, B1); PG8_BAR;
            PG8_LDA(At, 1, 1); PG8_STAGE(PG8_SA(1, 0), a3, voffA);
            PG8_BAR; PG8_WAIT_L(0); PG8_MMA(1, 0, At, B0); PG8_BAR; PG8_SCHED;
            PG8_STAGE(PG8_SB(1, 1), b3 + hstep, voffB);
            PG8_WAIT_V(6); PG8_BAR; PG8_MMA(1, 1, At, B1); PG8_BAR;
            }
        }
        if constexpr (ALIGN_EPI) { if (wr == 0) PG8_BAR; }
        if constexpr (!Epi::AFTER_DRAIN) { E(acc, cur, wr, wc, fr, fq); S.done(cur); }
        if (!has_next) break;
#pragma unroll
        for (int a = 0; a < 2; ++a)
#pragma unroll
            for (int b = 0; b < 2; ++b)
#pragma unroll
                for (int m = 0; m < 4; ++m)
#pragma unroll
                    for (int n = 0; n < 2; ++n) acc[a][b][m][n] = (f32x4){0.f, 0.f, 0.f, 0.f};
        cur = nxt; cA = nA; cB = nB; ++ui;
        if constexpr (ALIGN_EPI) { if (wr == 1) PG8_BAR; }
    }
    PG8_WAIT_V(0);
    if constexpr (!ALIGN_EPI) { if (wr == 0) PG8_BAR; }
    PG8_BAR;
    if constexpr (Epi::AFTER_DRAIN) { E.fused(acc, cur, wr, wc, fr, fq, lds, wid, lane); S.done(cur); }
#undef PG8_SA
#undef PG8_SB
#undef PG8_STAGE
#undef PG8_LDA
#undef PG8_LDB
#undef PG8_MMA
#undef PG8_WAIT_V
#undef PG8_WAIT_L
#undef PG8_BAR
#undef PG8_SCHED
}
}

struct EpiGU8 {
  static constexpr bool PERM = true, AFTER_DRAIN = false;
  const float* ssq; bf16_t* hbuf;
  __device__ __forceinline__ void operator()(const pg8::f32x4 (&acc)[2][2][4][2], const pg8::Unit& u, int wr, int wc, int fr, int fq) const {
    int z; asm volatile("v_mov_b32 %0, 0" : "=v"(z));
    const int row0 = u.pm * 256 + wr * 64 + fr + z, col0 = u.pn * 128 + wc * 32 + 8 * fq + z;
#pragma unroll
    for (int ai = 0; ai < 2; ++ai) {
      float rs[4];
#pragma unroll
      for (int m = 0; m < 4; ++m) { const f32x4 a = *(const f32x4*)(ssq + (unsigned)(row0 + ai * 128 + m * 16) * 16 + 4 * fq); rs[m] = (a[0] + a[1]) + (a[2] + a[3]); }
#pragma unroll
      for (int m = 0; m < 4; ++m) { float v = rs[m]; v += __shfl_xor(v, 16); v += __shfl_xor(v, 32); rs[m] = rsqrtf(v * (1.f / 1024.f) + EPS); }
#pragma unroll
      for (int m = 0; m < 4; ++m) {
        const float r = rs[m]; float v[8];
#pragma unroll
        for (int n = 0; n < 2; ++n)
#pragma unroll
          for (int c = 0; c < 4; ++c) { const float g = acc[ai][0][m][n][c] * r, uu = acc[ai][1][m][n][c] * r; v[4 * n + c] = g * sigm(g) * uu; }
        u32x4 w; w.x = pk2(v[0], v[1]); w.y = pk2(v[2], v[3]); w.z = pk2(v[4], v[5]); w.w = pk2(v[6], v[7]);
        *(u32x4*)(hbuf + (unsigned)(row0 + ai * 128 + m * 16) * DFF + col0) = w;
      }
      asm volatile("" ::: "memory");
    }
  }
};
struct EpiRes8 {
  static constexpr bool PERM = true, AFTER_DRAIN = false;
  typedef _Float16 h8_t __attribute__((ext_vector_type(8))); typedef float f8_t __attribute__((ext_vector_type(8)));
  _Float16* x16; float* xout; bf16_t* xb; float* ssq; float sc; int aux;
  __device__ __forceinline__ void operator()(const pg8::f32x4 (&acc)[2][2][4][2], const pg8::Unit& u, int wr, int wc, int fr, int fq) const {
    int z; asm volatile("v_mov_b32 %0, 0" : "=v"(z));
    const int row0 = u.pm * 256 + wr * 64 + fr + z, colb = u.pn * 256 + wc * 32 + 8 * fq + z;
#pragma unroll
    for (int ai = 0; ai < 2; ++ai)
#pragma unroll
      for (int m = 0; m < 4; ++m) {
        const int tok = row0 + ai * 128 + m * 16; float ss = 0.f;
#pragma unroll
        for (int bj = 0; bj < 2; ++bj) {
          const unsigned off = (unsigned)tok * DM + colb + 128 * bj;
          f8_t n = __builtin_convertvector(*(const h8_t*)(x16 + off), f8_t);
#pragma unroll
          for (int c = 0; c < 4; ++c) { n[c] += sc * acc[ai][bj][m][0][c]; n[4 + c] += sc * acc[ai][bj][m][1][c]; }
          if (aux) {
            *(h8_t*)(x16 + off) = __builtin_convertvector(n, h8_t);
            ss += ((n[0] * n[0] + n[1] * n[1]) + (n[2] * n[2] + n[3] * n[3])) + ((n[4] * n[4] + n[5] * n[5]) + (n[6] * n[6] + n[7] * n[7]));
          } else {
            *(f32x4*)(xout + off) = (f32x4){n[0], n[1], n[2], n[3]}; *(f32x4*)(xout + off + 4) = (f32x4){n[4], n[5], n[6], n[7]};
          }
        }
        if (aux) { ss += __shfl_xor(ss, 16); ss += __shfl_xor(ss, 32); if (fq == 0) ssq[(unsigned)tok * 16 + u.pn * 4 + wc] = ss; }
        if (m & 1) asm volatile("" ::: "memory");
      }
  }
};

template <bool FULL, int MODE, class Epi>
__device__ __forceinline__ void gemm_phase(const bf16_t* __restrict__ P, int ldp, int NP, const bf16_t* __restrict__ Q, int ldq, int K, char* smem, const Epi& epi) {
  constexpr int PITCH = 144, OPB = 256 * PITCH;
  const int G = gridDim.x, bid = blockIdx.x;
  const int PP = (NP % 4 == 0) ? 4 : ((NP % 2 == 0) ? 2 : 1);
  const int L = G >> 3;
  const bool patch = (G & 7) == 0 && (L % PP) == 0 && (64 % (L / PP)) == 0;
  const int xcd = bid & 7, loc = bid >> 3, PQ = patch ? L / PP : 1, npp = NP / PP, npatch = patch ? npp * (64 / PQ) : 0;
  const int niter = (MODE == 1) ? (256 + G - 1) / G : (patch ? (npatch + 7) / 8 : (NP * 64 + G - 1) / G);
  auto coords = [&](int it, int& p0, int& q0) -> bool {
    if (MODE == 1) { const int t = bid + it * G; p0 = (t >> 5) * 128; q0 = t * 256; return t < 256; }
    if (patch) { const int pidx = xcd + 8 * it; p0 = ((pidx % npp) * PP + loc % PP) * 256; q0 = ((pidx / npp) * PQ + loc / PP) * 256; return pidx < npatch; }
    const int t = bid + it * G; p0 = (t % NP) * 256; q0 = (t / NP) * 256; return t < NP * 64;
  };
  int tid = threadIdx.x; asm volatile("" : "+v"(tid));
  const int lane = tid & 63, wid = tid >> 6;
  const int wp = wid >> 2, wq = wid & 3;
  const int r = lane & 31, h = lane >> 5;
  const int lr = tid >> 3, lc = tid & 7;
  const int nk = K >> 6;
  const int rot = (int)((unsigned)loc % (unsigned)nk);
  char* sP = smem; char* sQ = smem + 2 * OPB;
  const int wofs = lr * PITCH + lc * 16;
  const int aofs = (wp * 128 + r) * PITCH + h * 16;
  const int bofs = (wq * 64 + r) * PITCH + h * 16;
  int it = 0, p0 = 0, q0 = 0;
  if (niter <= 0 || !coords(0, p0, q0)) return;
  const bf16_t* gp = P + (size_t)(p0 + lr) * ldp + lc * 8;
  const bf16_t* gq = Q + (size_t)(q0 + lr) * ldq + lc * 8;
  u32x4 rp[4], rq[4];
#pragma unroll
  for (int j = 0; j < 4; ++j) { rp[j] = *(const u32x4*)(gp + (size_t)(64 * j) * ldp + rot * 64); rq[j] = *(const u32x4*)(gq + (size_t)(64 * j) * ldq + rot * 64); }
#pragma unroll 1
  for (;;) {
    float pre[2];
    epi.prefetch(pre, q0 + wq * 64, lane);
    f32x16 acc[4][2];
#pragma unroll
    for (int a = 0; a < 4; ++a)
#pragma unroll
      for (int b = 0; b < 2; ++b)
#pragma unroll
        for (int i = 0; i < 16; ++i) acc[a][b][i] = 0.f;
    __syncthreads();
#pragma unroll
    for (int j = 0; j < 4; ++j) { *(u32x4*)(sP + wofs + j * 64 * PITCH) = rp[j]; *(u32x4*)(sQ + wofs + j * 64 * PITCH) = rq[j]; }
    {
      int kk = 1 + rot; if (kk >= nk) kk -= nk;
      const int ko = kk * 64;
#pragma unroll
      for (int j = 0; j < 4; ++j) { rp[j] = *(const u32x4*)(gp + (size_t)(64 * j) * ldp + ko); rq[j] = *(const u32x4*)(gq + (size_t)(64 * j) * ldq + ko); }
    }
#pragma unroll 1
    for (int kt = 0; kt < nk; ++kt) {
      const int cur = kt & 1;
      __syncthreads();
      if (kt + 1 < nk) {
        char* dP = sP + (cur ^ 1) * OPB + wofs; char* dQ = sQ + (cur ^ 1) * OPB + wofs;
#pragma unroll
        for (int j = 0; j < 4; ++j) { *(u32x4*)(dP + j * 64 * PITCH) = rp[j]; *(u32x4*)(dQ + j * 64 * PITCH) = rq[j]; }
        if (kt + 2 < nk) {
          int kk = kt + 2 + rot; if (kk >= nk) kk -= nk;
          const int ko = kk * 64;
#pragma unroll
          for (int j = 0; j < 4; ++j) { rp[j] = *(const u32x4*)(gp + (size_t)(64 * j) * ldp + ko); rq[j] = *(const u32x4*)(gq + (size_t)(64 * j) * ldq + ko); }
        }
      }
      const char* ab = sP + cur * OPB + aofs; const char* bb = sQ + cur * OPB + bofs;
#pragma unroll
      for (int ks = 0; ks < 4; ++ks) {
        bf16x8 a[4], b[2];
#pragma unroll
        for (int pi = 0; pi < 4; ++pi) a[pi] = *(const bf16x8*)(ab + pi * 32 * PITCH + ks * 32);
#pragma unroll
        for (int qi = 0; qi < 2; ++qi) b[qi] = *(const bf16x8*)(bb + qi * 32 * PITCH + ks * 32);
#pragma unroll
        for (int pi = 0; pi < 4; ++pi)
#pragma unroll
          for (int qi = 0; qi < 2; ++qi) acc[pi][qi] = MFMA(a[pi], b[qi], acc[pi][qi]);
      }
    }
    int np0 = 0, nq0 = 0;
    const bool has_next = (it + 1 < niter) && coords(it + 1, np0, nq0);
    if (Epi::XPF && has_next) {
      gp = P + (size_t)(np0 + lr) * ldp + lc * 8; gq = Q + (size_t)(nq0 + lr) * ldq + lc * 8;
#pragma unroll
      for (int j = 0; j < 4; ++j) { rp[j] = *(const u32x4*)(gp + (size_t)(64 * j) * ldp + rot * 64); rq[j] = *(const u32x4*)(gq + (size_t)(64 * j) * ldq + rot * 64); }
    }
    if constexpr (Epi::LDS_OUT) {
      __syncthreads();
      epi.to_lds(*(f32x16 (*)[2][2])(&acc[0]), smem, wp * 64, wq * 64, lane, pre);
      epi.to_lds(*(f32x16 (*)[2][2])(&acc[2]), smem, wp * 64 + 32, wq * 64, lane, pre);
      __syncthreads();
      {
        bf16_t* ob = epi.out_base() + (size_t)q0 * Epi::OUT_LD + (p0 >> 1);
        const int orow = tid >> 4, och = tid & 15;
#pragma unroll
        for (int ps = 0; ps < 8; ++ps) {
          const int row = ps * 32 + orow;
          const u32x4 v = *(const u32x4*)(smem + row * 264 + och * 16);
          *(u32x4*)(ob + (size_t)row * Epi::OUT_LD + och * 8) = v;
        }
      }
    } else if constexpr (FULL) {
      epi(acc, p0 + wp * 128, q0 + wq * 64, lane, pre);
    } else {
      epi(*(f32x16 (*)[2][2])(&acc[0]), p0 + wp * 128, q0 + wq * 64, lane, pre);
      epi(*(f32x16 (*)[2][2])(&acc[2]), p0 + wp * 128 + 64, q0 + wq * 64, lane, pre);
    }
    if (!has_next) break;
    ++it; p0 = np0; q0 = nq0;
    if (!Epi::XPF) {
      gp = P + (size_t)(p0 + lr) * ldp + lc * 8; gq = Q + (size_t)(q0 + lr) * ldq + lc * 8;
#pragma unroll
      for (int j = 0; j < 4; ++j) { rp[j] = *(const u32x4*)(gp + (size_t)(64 * j) * ldp + rot * 64); rq[j] = *(const u32x4*)(gq + (size_t)(64 * j) * ldq + rot * 64); }
    }
  }
}


__device__ __forceinline__ void wave_atomic_max_pos(float v, unsigned* dst) {
#pragma unroll
  for (int o = 32; o >= 1; o >>= 1) v = fmaxf(v, __shfl_xor(v, o));
  if ((threadIdx.x & 63) == 0) atomicMax(dst + (blockIdx.x & 7) * 64, __float_as_uint(v));
}
__device__ __forceinline__ float kmax_of(const unsigned* kmx, int idx) { unsigned m = 0u;
#pragma unroll
  for (int sl = 0; sl < 8; ++sl) m = max(m, kmx[sl * 64 + idx]);
  return sqrtf(__uint_as_float(m)); }
constexpr size_t O_KMAX = 14336;

struct EpiGU {
  static constexpr bool LDS_OUT = true;
  static constexpr bool XPF = true;
  const float* ssq; bf16_t* hbuf;
  static constexpr int OUT_LD = DFF;
  __device__ __forceinline__ bf16_t* out_base() const { return hbuf; }
  __device__ __forceinline__ void to_lds(f32x16 (&acc)[2][2], char* smem, int hl0, int tl0, int lane, const float (&pre)[2]) const {
    const int r = lane & 31, h = lane >> 5;
#pragma unroll
    for (int qi = 0; qi < 2; ++qi) {
      const float rs = pre[qi];
      char* dst = smem + (tl0 + 32 * qi + r) * 264 + (hl0 + 4 * h) * 2;
#pragma unroll
      for (int i4 = 0; i4 < 4; ++i4) {
        float v[4];
#pragma unroll
        for (int c = 0; c < 4; ++c) { const float g = acc[0][qi][4 * i4 + c] * rs, u = acc[1][qi][4 * i4 + c] * rs; v[c] = g * sigm(g) * u; }
        u32x2 w; w.x = pk2(v[0], v[1]); w.y = pk2(v[2], v[3]);
        *(u32x2*)(dst + 16 * i4) = w;
      }
    }
  }
  __device__ __forceinline__ void prefetch(float (&pre)[2], int tbase, int lane) const { const int r = lane & 31;
#pragma unroll
    for (int qi = 0; qi < 2; ++qi) pre[qi] = rstd16(ssq, tbase + 32 * qi + r); }
  __device__ __forceinline__ void operator()(f32x16 (&acc)[2][2], int fbase, int tbase, int lane, const float (&pre)[2]) const {
    const int r = lane & 31, h = lane >> 5, j0 = fbase >> 1;
#pragma unroll
    for (int qi = 0; qi < 2; ++qi) {
      const int tok = tbase + 32 * qi + r; const float rs = pre[qi];
      bf16_t* hp = hbuf + (unsigned)tok * DFF + j0 + 4 * h;
#pragma unroll
      for (int i4 = 0; i4 < 4; ++i4) {
        float v[4];
#pragma unroll
        for (int c = 0; c < 4; ++c) { const float g = acc[0][qi][4 * i4 + c] * rs, u = acc[1][qi][4 * i4 + c] * rs; v[c] = g * sigm(g) * u; }
        u32x2 w; w.x = pk2(v[0], v[1]); w.y = pk2(v[2], v[3]);
        *(u32x2*)(hp + 8 * i4) = w;
      }
    }
  }
};

struct EpiResid {
  static constexpr bool LDS_OUT = false;
  static constexpr bool XPF = true;
  const float* xold; float* xnew; bf16_t* xb; float* ssq; float sc; int aux;
  __device__ __forceinline__ void prefetch(float (&pre)[2], int tbase, int lane) const { pre[0] = 0.f; pre[1] = 0.f; }
  __device__ __forceinline__ void operator()(f32x16 (&acc)[2][2], int fbase, int tbase, int lane, const float (&pre)[2]) const {
    const int r = lane & 31, h = lane >> 5;
#pragma unroll
    for (int qi = 0; qi < 2; ++qi) {
      const int tok = tbase + 32 * qi + r; float ss = 0.f;
#pragma unroll
      for (int pi = 0; pi < 2; ++pi)
#pragma unroll
        for (int i4 = 0; i4 < 4; ++i4) {
          const size_t off = (unsigned)tok * DM + fbase + 32 * pi + 8 * i4 + 4 * h;
          const f32x4 xo = *(const f32x4*)(xold + off); f32x4 xn;
#pragma unroll
          for (int c = 0; c < 4; ++c) xn[c] = xo[c] + sc * acc[pi][qi][4 * i4 + c];
          *(f32x4*)(xnew + off) = xn;
          if (aux) { u32x2 w; w.x = pk2(xn[0], xn[1]); w.y = pk2(xn[2], xn[3]); *(u32x2*)(xb + off) = w; ss += (xn[0] * xn[0] + xn[1] * xn[1]) + (xn[2] * xn[2] + xn[3] * xn[3]); }
        }
      if (aux) { ss += __shfl_xor(ss, 32); if (h == 0) ssq[(unsigned)tok * 16 + (fbase >> 6)] = ss; }
    }
  }
};

__device__ __forceinline__ float ss64(const float (&v)[2][16]) {
  float s = 0.f;
#pragma unroll
  for (int pi = 0; pi < 2; ++pi)
#pragma unroll
    for (int i = 0; i < 16; ++i) s += v[pi][i] * v[pi][i];
  return s + __shfl_xor(s, 32);
}
__device__ __forceinline__ void store_tok64_bf16(bf16_t* dst  , const float (&v)[2][16], int h) {
#pragma unroll
  for (int pi = 0; pi < 2; ++pi)
#pragma unroll
    for (int i4 = 0; i4 < 4; ++i4) { u32x2 w; w.x = pk2(v[pi][4 * i4], v[pi][4 * i4 + 1]); w.y = pk2(v[pi][4 * i4 + 2], v[pi][4 * i4 + 3]); *(u32x2*)(dst + 32 * pi + 8 * i4 + 4 * h) = w; }
}
__device__ __forceinline__ void store_feat_major(bf16_t* dst, unsigned pitch, const float (&v)[2][16], int h) {
#pragma unroll
  for (int pi = 0; pi < 2; ++pi)
#pragma unroll
    for (int i = 0; i < 16; ++i) dst[(unsigned)(32 * pi + 8 * (i >> 2) + 4 * h + (i & 3)) * pitch] = f2bf(v[pi][i]);
}

struct EpiEvIn {
  static constexpr bool LDS_OUT = false;
  static constexpr bool XPF = true;
  const float* ssq; const float* sgu_norm; const float* q_norm; const float* k_norm; const float* cos64; const float* sin64;
  bf16_t* ub; bf16_t* vt; bf16_t* qb; bf16_t* kb; bf16_t* vtb; unsigned* kmax2;
  __device__ __forceinline__ void prefetch(float (&pre)[2], int tbase, int lane) const { const int r = lane & 31;
#pragma unroll
    for (int qi = 0; qi < 2; ++qi) pre[qi] = rstd16(ssq, tbase + 32 * qi + r); }
  __device__ __forceinline__ void operator()(f32x16 (&acc)[2][2], int fbase, int tbase, int lane, const float (&pre)[2]) const {
    const int r = lane & 31, h = lane >> 5, gidx = fbase >> 6;
#pragma unroll
    for (int qi = 0; qi < 2; ++qi) {
      const int tok = tbase + 32 * qi + r; const float rs = pre[qi];
      const int bb = tok >> 13, pos = tok & (S - 1);
      float v[2][16];
#pragma unroll
      for (int pi = 0; pi < 2; ++pi)
#pragma unroll
        for (int i = 0; i < 16; ++i) v[pi][i] = acc[pi][qi][i] * rs;
      if (gidx < 8) {
#pragma unroll
        for (int pi = 0; pi < 2; ++pi)
#pragma unroll
          for (int i = 0; i < 16; ++i) v[pi][i] = gelu_tanh(v[pi][i]);
        store_tok64_bf16(ub + (unsigned)tok * 512 + gidx * 64, v, h);
      } else if (gidx < 16) {
        const int g = gidx - 8;
#pragma unroll
        for (int pi = 0; pi < 2; ++pi)
#pragma unroll
          for (int i = 0; i < 16; ++i) v[pi][i] = gelu_tanh(v[pi][i]);
        const float rn = rsqrtf(ss64(v) * (1.f / 64.f) + EPS);
#pragma unroll
        for (int pi = 0; pi < 2; ++pi)
#pragma unroll
          for (int i = 0; i < 16; ++i) v[pi][i] *= rn * sgu_norm[g * 64 + 32 * pi + 8 * (i >> 2) + 4 * h + (i & 3)];
        store_feat_major(vt + ((unsigned)(g * 128 + (tok >> 7)) * 64) * 128 + (tok & 127), 128, v, h);
      } else if (gidx < 32) {
        const bool isq = gidx < 24; const int hm = isq ? gidx - 16 : gidx - 24;
        const float* gn = isq ? q_norm : k_norm;
        const float rn = rsqrtf(ss64(v) * (1.f / 64.f) + EPS) * (isq ? 0.125f * LOG2E : 1.f);
#pragma unroll
        for (int i = 0; i < 16; ++i) {
          const int d = 8 * (i >> 2) + 4 * h + (i & 3);
          const float x1 = v[0][i] * rn * gn[d], x2 = v[1][i] * rn * gn[d + 32];
          const float c = cos64[pos * 32 + d], s = sin64[pos * 32 + d];
          v[0][i] = x1 * c - x2 * s; v[1][i] = x1 * s + x2 * c;
        }
        store_tok64_bf16((isq ? qb : kb) + ((unsigned)(bb * 8 + hm) * S + pos) * 64, v, h);
        if (!isq) wave_atomic_max_pos(ss64(v), kmax2 + bb * 8 + hm);
      } else {
        const int hv = (gidx - 32) >> 1, eh = (gidx - 32) & 1;
        store_feat_major(vtb + ((unsigned)(bb * 4 + hv) * 128 + 64 * eh) * S + pos, S, v, h);
      }
    }
  }
};

__device__ __forceinline__ void rope32(float (&v)[16], const float* __restrict__ cos32, const float* __restrict__ sin32, int p, int h) {
#pragma unroll
  for (int i = 0; i < 8; ++i) {
    const int d = 8 * (i >> 2) + 4 * h + (i & 3);
    const float c = cos32[p * 16 + d], s = sin32[p * 16 + d];
    const float x1 = v[i], x2 = v[i + 8];
    v[i] = x1 * c - x2 * s; v[i + 8] = x1 * s + x2 * c;
  }
}

struct EpiOdIn {
  static constexpr bool LDS_OUT = false;
  static constexpr bool XPF = true;
  const float* ssq; const float* gq_norm; const float* gk_norm; const float* cos32; const float* sin32;
  bf16_t* cq; bf16_t* ckv; float* ssq2; float* kpe; bf16_t* qd; bf16_t* kd; bf16_t* vtd; unsigned* kmax2;
  __device__ __forceinline__ void prefetch(float (&pre)[2], int tbase, int lane) const { const int r = lane & 31;
#pragma unroll
    for (int qi = 0; qi < 2; ++qi) pre[qi] = rstd16(ssq, tbase + 32 * qi + r); }
  __device__ __forceinline__ void operator()(f32x16 (&acc)[2][2], int fbase, int tbase, int lane, const float (&pre)[2]) const {
    const int r = lane & 31, h = lane >> 5, gidx = fbase >> 6;
    if (gidx >= 19) return;
#pragma unroll
    for (int qi = 0; qi < 2; ++qi) {
      const int tok = tbase + 32 * qi + r; const float rs = pre[qi];
      const int bb = tok >> 13, pos = tok & (S - 1);
      float v[2][16];
#pragma unroll
      for (int pi = 0; pi < 2; ++pi)
#pragma unroll
        for (int i = 0; i < 16; ++i) v[pi][i] = acc[pi][qi][i] * rs;
      if (gidx < 6) {
        const float ss = ss64(v);
        if (h == 0) ssq2[(unsigned)tok * 8 + gidx] = ss;
        if (gidx < 4) store_tok64_bf16(cq + (unsigned)tok * 256 + gidx * 64, v, h);
        else store_tok64_bf16(ckv + (unsigned)tok * 128 + (gidx - 4) * 64, v, h);
      } else if (gidx == 6) {
#pragma unroll
        for (int i4 = 0; i4 < 4; ++i4) { f32x4 w = {v[0][4 * i4], v[0][4 * i4 + 1], v[0][4 * i4 + 2], v[0][4 * i4 + 3]}; *(f32x4*)(kpe + (unsigned)tok * 32 + 8 * i4 + 4 * h) = w; }
      } else if (gidx < 17) {
        const bool isq = gidx < 15; const float* gn = isq ? gq_norm : gk_norm;
        const float rn = rsqrtf(ss64(v) * (1.f / 64.f) + EPS) * (isq ? 0.125f * LOG2E : 1.f);
#pragma unroll
        for (int pi = 0; pi < 2; ++pi)
#pragma unroll
          for (int i = 0; i < 16; ++i) v[pi][i] *= rn * gn[32 * pi + 8 * (i >> 2) + 4 * h + (i & 3)];
        rope32(v[0], cos32, sin32, pos >> 6, h);
        rope32(v[1], cos32, sin32, pos & 63, h);
        if (isq) store_tok64_bf16(qd + ((unsigned)(bb * 8 + (gidx - 7)) * S + pos) * 64, v, h);
        else { store_tok64_bf16(kd + ((unsigned)(bb * 2 + (gidx - 15)) * S + pos) * 64, v, h); wave_atomic_max_pos(ss64(v), kmax2 + 32 + bb * 2 + (gidx - 15)); }
      } else {
        store_feat_major(vtd + ((unsigned)(bb * 2 + (gidx - 17)) * 64) * S + pos, S, v, h);
      }
    }
  }
};

struct EpiUq {
  static constexpr bool LDS_OUT = false;
  static constexpr bool XPF = false;
  const float* ssq2; const float* qn; const float* cos32; const float* sin32; bf16_t* qc;
  __device__ __forceinline__ void prefetch(float (&pre)[2], int tbase, int lane) const { const int r = lane & 31;
#pragma unroll
    for (int qi = 0; qi < 2; ++qi) { const f32x4 sq = *(const f32x4*)(ssq2 + (unsigned)(tbase + 32 * qi + r) * 8); pre[qi] = rsqrtf(((sq[0] + sq[1]) + (sq[2] + sq[3])) * (1.f / 256.f) + EPS); } }
  __device__ __forceinline__ void operator()(f32x16 (&acc)[4][2], int fbase, int tbase, int lane, const float (&pre)[2]) const {
    const int r = lane & 31, h = lane >> 5, head = fbase >> 7;
#pragma unroll
    for (int qi = 0; qi < 2; ++qi) {
    const int tok = tbase + 32 * qi + r, bb = tok >> 13, pos = tok & (S - 1);
    const float rs = pre[qi];
    float v[3][16]; float ss = 0.f;
#pragma unroll
    for (int pi = 0; pi < 3; ++pi)
#pragma unroll
      for (int i = 0; i < 16; ++i) { v[pi][i] = acc[pi][qi][i] * rs; ss += v[pi][i] * v[pi][i]; }
    ss += __shfl_xor(ss, 32);
    const float rn = rsqrtf(ss * (1.f / 96.f) + EPS) * (0.10206207261596575f * LOG2E);
#pragma unroll
    for (int pi = 0; pi < 3; ++pi)
#pragma unroll
      for (int i = 0; i < 16; ++i) v[pi][i] *= rn * qn[32 * pi + 8 * (i >> 2) + 4 * h + (i & 3)];
    rope32(v[2], cos32, sin32, pos, h);
    bf16_t* dst = qc + ((unsigned)(bb * 8 + head) * S + pos) * 96;
#pragma unroll
    for (int pi = 0; pi < 3; ++pi)
#pragma unroll
      for (int i4 = 0; i4 < 4; ++i4) { u32x2 w; w.x = pk2(v[pi][4 * i4], v[pi][4 * i4 + 1]); w.y = pk2(v[pi][4 * i4 + 2], v[pi][4 * i4 + 3]); *(u32x2*)(dst + 32 * pi + 8 * i4 + 4 * h) = w; }
    }
  }
};

struct EpiUkv {
  static constexpr bool LDS_OUT = false;
  static constexpr bool XPF = false;
  const float* ssq2; const float* kn; const float* kpe; const float* cos32; const float* sin32; bf16_t* kc; bf16_t* vtc; unsigned* kmax2;
  __device__ __forceinline__ void prefetch(float (&pre)[2], int tbase, int lane) const { const int r = lane & 31;
#pragma unroll
    for (int qi = 0; qi < 2; ++qi) { const unsigned t8 = (unsigned)(tbase + 32 * qi + r) * 8; pre[qi] = rsqrtf((ssq2[t8 + 4] + ssq2[t8 + 5]) * (1.f / 128.f) + EPS); } }
  __device__ __forceinline__ void operator()(f32x16 (&acc)[2][2], int fbase, int tbase, int lane, const float (&pre)[2]) const {
    int z; asm volatile("v_mov_b32 %0, 0" : "=v"(z));
    const int r = (lane & 31) + z, h = lane >> 5, head = fbase >> 7, isv = (fbase >> 6) & 1;
    float kmx_run = 0.f;
#pragma unroll
    for (int qi = 0; qi < 2; ++qi) {
      const int tok = tbase + 32 * qi + r, bb = tok >> 13, pos = tok & (S - 1);
      const float rs = pre[qi];
      float v[2][16];
#pragma unroll
      for (int pi = 0; pi < 2; ++pi)
#pragma unroll
        for (int i = 0; i < 16; ++i) v[pi][i] = acc[pi][qi][i] * rs;
      if (isv) {
        store_feat_major(vtc + ((unsigned)(bb * 8 + head) * 64) * S + pos, S, v, h);
      } else {
        float pe[16]; float ss = 0.f;
#pragma unroll
        for (int i4 = 0; i4 < 4; ++i4) { const f32x4 w = *(const f32x4*)(kpe + (unsigned)tok * 32 + 8 * i4 + 4 * h);
#pragma unroll
          for (int c = 0; c < 4; ++c) { pe[4 * i4 + c] = w[c]; ss += w[c] * w[c]; } }
#pragma unroll
        for (int pi = 0; pi < 2; ++pi)
#pragma unroll
          for (int i = 0; i < 16; ++i) ss += v[pi][i] * v[pi][i];
        ss += __shfl_xor(ss, 32);
        const float rn = rsqrtf(ss * (1.f / 96.f) + EPS);
#pragma unroll
        for (int pi = 0; pi < 2; ++pi)
#pragma unroll
          for (int i = 0; i < 16; ++i) v[pi][i] *= rn * kn[32 * pi + 8 * (i >> 2) + 4 * h + (i & 3)];
#pragma unroll
        for (int i = 0; i < 16; ++i) pe[i] *= rn * kn[64 + 8 * (i >> 2) + 4 * h + (i & 3)];
        rope32(pe, cos32, sin32, pos, h);
        { float kk = 0.f;
#pragma unroll
          for (int i = 0; i < 16; ++i) kk += pe[i] * pe[i];
          kmx_run = fmaxf(kmx_run, ss64(v) + kk + __shfl_xor(kk, 32)); }
        bf16_t* dst = kc + ((unsigned)(bb * 8 + head) * S + pos) * 96;
        store_tok64_bf16(dst, v, h);
#pragma unroll
        for (int i4 = 0; i4 < 4; ++i4) { u32x2 w; w.x = pk2(pe[4 * i4], pe[4 * i4 + 1]); w.y = pk2(pe[4 * i4 + 2], pe[4 * i4 + 3]); *(u32x2*)(dst + 64 + 8 * i4 + 4 * h) = w; }
      }
    }
    if (!isv) wave_atomic_max_pos(kmx_run, kmax2 + 16 + (tbase >> 13) * 8 + head);
  }
};

struct EpiGmlp {
  static constexpr bool LDS_OUT = false;
  static constexpr bool XPF = false;
  const float* b_s; const bf16_t* ub; bf16_t* mix;
  __device__ __forceinline__ void prefetch(float (&pre)[2], int tbase, int lane) const { pre[0] = 0.f; pre[1] = 0.f; }
  __device__ __forceinline__ void operator()(f32x16 (&acc)[2][2], int fbase, int tbase, int lane, const float (&pre)[2]) const {
    const int r = lane & 31, h = lane >> 5;
    const int g = tbase >> 13, chunk = (tbase & 8191) >> 6;
    fbase -= g * 128;
    if (fbase >= 128) return;
    const float* bs = b_s + g * 128 + fbase + 4 * h;
#pragma unroll
    for (int qi = 0; qi < 2; ++qi) {
      const unsigned tok0 = (unsigned)(chunk * 128 + fbase + 4 * h);
      const unsigned uo = tok0 * 512u + (unsigned)(g * 64 + 32 * qi + r), mo = tok0 * 1024u + (unsigned)(g * 64 + 32 * qi + r);
#pragma unroll
      for (int pi = 0; pi < 2; ++pi)
#pragma unroll
        for (int i = 0; i < 16; ++i) {
          const int io = 32 * pi + 8 * (i >> 2) + (i & 3);
          const float uu = bf2f(ub[uo + (unsigned)(io * 512)]);
          mix[mo + (unsigned)(io * 1024)] = f2bf(uu * (acc[pi][qi][i] + bs[io]));
        }
    }
  }
};


__device__ __forceinline__ float grp_sum(float v) { v += __shfl_xor(v, 16); v += __shfl_xor(v, 32); return v; }
__device__ __forceinline__ float lane32_partner(float a, int lane) {
  auto rr = __builtin_amdgcn_permlane32_swap(__float_as_uint(a), __float_as_uint(a), false, false);
  return __uint_as_float(lane < 32 ? rr[1] : rr[0]);
}
__device__ __forceinline__ void st8_bf16(bf16_t* dst, const float (&v)[8]) { u32x4 w; w.x = pk2(v[0], v[1]); w.y = pk2(v[2], v[3]); w.z = pk2(v[4], v[5]); w.w = pk2(v[6], v[7]); *(u32x4*)dst = w; }

struct EpiEvIn8 {
  static constexpr bool PERM = true, AFTER_DRAIN = false;
  const float* ssq; const float* sgu_norm; const float* q_norm; const float* k_norm; const float* cos64; const float* sin64;
  bf16_t* ub; bf16_t* vt; bf16_t* qb; bf16_t* kb; bf16_t* vtb; unsigned* kmax2;
  __device__ __forceinline__ void operator()(const pg8::f32x4 (&acc)[2][2][4][2], const pg8::Unit& u, int wr, int wc, int fr, int fq) const {
    int z; asm volatile("v_mov_b32 %0, 0" : "=v"(z));
    const int gi = 4 * u.pn + wc;
    const int row0 = u.pm * 256 + wr * 64 + fr + z;
    float kmx_run = 0.f;
#pragma unroll
    for (int ai = 0; ai < 2; ++ai) {
      float rs[4];
#pragma unroll
      for (int m = 0; m < 4; ++m) { const f32x4 a = *(const f32x4*)(ssq + (unsigned)(row0 + ai * 128 + m * 16) * 16 + 4 * fq); rs[m] = (a[0] + a[1]) + (a[2] + a[3]); }
#pragma unroll
      for (int m = 0; m < 4; ++m) rs[m] = rsqrtf(grp_sum(rs[m]) * (1.f / 1024.f) + EPS);
#pragma unroll
      for (int m = 0; m < 4; ++m) {
        const int tok = row0 + ai * 128 + m * 16, bb = tok >> 13, pos = tok & (S - 1);
        float v[2][8];
#pragma unroll
        for (int bj = 0; bj < 2; ++bj)
#pragma unroll
          for (int n = 0; n < 2; ++n)
#pragma unroll
            for (int c = 0; c < 4; ++c) v[bj][4 * n + c] = acc[ai][bj][m][n][c] * rs[m];
        if (gi < 8) {
#pragma unroll
          for (int bj = 0; bj < 2; ++bj) {
#pragma unroll
            for (int e = 0; e < 8; ++e) v[bj][e] = gelu_tanh(v[bj][e]);
            st8_bf16(ub + (unsigned)tok * 512 + gi * 64 + 32 * bj + 8 * fq, v[bj]);
          }
        } else if (gi < 16) {
          const int g = gi - 8; float ss = 0.f;
#pragma unroll
          for (int bj = 0; bj < 2; ++bj)
#pragma unroll
            for (int e = 0; e < 8; ++e) { v[bj][e] = gelu_tanh(v[bj][e]); ss += v[bj][e] * v[bj][e]; }
          const float rn = rsqrtf(grp_sum(ss) * (1.f / 64.f) + EPS);
          bf16_t* dst = vt + ((unsigned)(g * 128 + (tok >> 7)) * 64 + 8 * fq) * 128 + (tok & 127);
#pragma unroll
          for (int bj = 0; bj < 2; ++bj)
#pragma unroll
            for (int e = 0; e < 8; ++e) dst[(32 * bj + e) * 128] = f2bf(v[bj][e] * rn * sgu_norm[g * 64 + 32 * bj + 8 * fq + e]);
        } else if (gi < 32) {
          const bool isq = gi < 24; const int hm = isq ? gi - 16 : gi - 24;
          const float* gn = isq ? q_norm : k_norm;
          float ss = 0.f;
#pragma unroll
          for (int bj = 0; bj < 2; ++bj)
#pragma unroll
            for (int e = 0; e < 8; ++e) ss += v[bj][e] * v[bj][e];
          const float rn = rsqrtf(grp_sum(ss) * (1.f / 64.f) + EPS) * (isq ? 0.125f * LOG2E : 1.f);
          const f32x4 c0 = *(const f32x4*)(cos64 + (unsigned)pos * 32 + 8 * fq), c1 = *(const f32x4*)(cos64 + (unsigned)pos * 32 + 8 * fq + 4);
          const f32x4 s0 = *(const f32x4*)(sin64 + (unsigned)pos * 32 + 8 * fq), s1 = *(const f32x4*)(sin64 + (unsigned)pos * 32 + 8 * fq + 4);
          float kk = 0.f;
#pragma unroll
          for (int e = 0; e < 8; ++e) {
            const float x1 = v[0][e] * rn * gn[8 * fq + e], x2 = v[1][e] * rn * gn[32 + 8 * fq + e];
            const float cc = e < 4 ? c0[e & 3] : c1[e & 3], sn = e < 4 ? s0[e & 3] : s1[e & 3];
            v[0][e] = x1 * cc - x2 * sn; v[1][e] = x1 * sn + x2 * cc;
            kk += v[0][e] * v[0][e] + v[1][e] * v[1][e];
          }
          bf16_t* dst = (isq ? qb : kb) + ((unsigned)(bb * 8 + hm) * S + pos) * 64 + 8 * fq;
          st8_bf16(dst, v[0]); st8_bf16(dst + 32, v[1]);
          if (!isq) kmx_run = fmaxf(kmx_run, grp_sum(kk));
        } else {
          const int hv = (gi - 32) >> 1, eh = (gi - 32) & 1;
          bf16_t* dst = vtb + ((unsigned)(bb * 4 + hv) * 128 + 64 * eh + 8 * fq) * S + pos;
#pragma unroll
          for (int bj = 0; bj < 2; ++bj)
#pragma unroll
            for (int e = 0; e < 8; ++e) dst[(unsigned)(32 * bj + e) * S] = f2bf(v[bj][e]);
        }
        if (m & 1) asm volatile("" ::: "memory");
      }
    }
    if (gi >= 24 && gi < 32) wave_atomic_max_pos(kmx_run, kmax2 + ((u.pm * 256) >> 13) * 8 + (gi - 24));
  }
};

struct EpiOdIn8 {
  static constexpr bool PERM = true, AFTER_DRAIN = false;
  const float* ssq; const float* gq_norm; const float* gk_norm; const float* cos32; const float* sin32;
  bf16_t* cq; bf16_t* ckv; float* ssq2; float* kpe; bf16_t* qd; bf16_t* kd; bf16_t* vtd; unsigned* kmax2;
  __device__ __forceinline__ void operator()(const pg8::f32x4 (&acc)[2][2][4][2], const pg8::Unit& u, int wr, int wc, int fr, int fq0) const {
    int z; asm volatile("v_mov_b32 %0, 0" : "=v"(z));
    const int fq = fq0 + z;
    const int gi = 4 * u.pn + wc;
    if (gi >= 19) return;
    const int lane = fr + 16 * fq;
    const int row0 = u.pm * 256 + wr * 64 + 4 * fr + z;
    float kmx_run = 0.f;
#pragma unroll
    for (int ai = 0; ai < 2; ++ai) {
      float rs[4];
#pragma unroll
      for (int m = 0; m < 4; ++m) { const f32x4 a = *(const f32x4*)(ssq + (unsigned)(row0 + ai * 128 + m) * 16 + 4 * fq); rs[m] = (a[0] + a[1]) + (a[2] + a[3]); }
#pragma unroll
      for (int m = 0; m < 4; ++m) rs[m] = rsqrtf(grp_sum(rs[m]) * (1.f / 1024.f) + EPS);
      if (gi >= 17) {
        const int tok0 = row0 + ai * 128, bb0 = tok0 >> 13, pos0 = tok0 & (S - 1);
        bf16_t* dst = vtd + ((unsigned)(bb0 * 2 + (gi - 17)) * 64 + 8 * fq) * S + pos0;
#pragma unroll
        for (int bj = 0; bj < 2; ++bj)
#pragma unroll
          for (int n = 0; n < 2; ++n)
#pragma unroll
            for (int c = 0; c < 4; ++c) {
              u32x2 w; w.x = pk2(acc[ai][bj][0][n][c] * rs[0], acc[ai][bj][1][n][c] * rs[1]); w.y = pk2(acc[ai][bj][2][n][c] * rs[2], acc[ai][bj][3][n][c] * rs[3]);
              *(u32x2*)(dst + (unsigned)(32 * bj + 4 * n + c) * S) = w;
            }
        asm volatile("" ::: "memory");
        continue;
      }
#pragma unroll
      for (int m = 0; m < 4; ++m) {
        const int tok = row0 + ai * 128 + m, bb = tok >> 13, pos = tok & (S - 1);
        float v[2][8];
#pragma unroll
        for (int bj = 0; bj < 2; ++bj)
#pragma unroll
          for (int n = 0; n < 2; ++n)
#pragma unroll
            for (int c = 0; c < 4; ++c) v[bj][4 * n + c] = acc[ai][bj][m][n][c] * rs[m];
        if (gi < 6) {
          float ss = 0.f;
#pragma unroll
          for (int bj = 0; bj < 2; ++bj)
#pragma unroll
            for (int e = 0; e < 8; ++e) ss += v[bj][e] * v[bj][e];
          ss = grp_sum(ss);
          if (fq == 0) ssq2[(unsigned)tok * 8 + gi] = ss;
          bf16_t* dst = (gi < 4) ? cq + (unsigned)tok * 256 + gi * 64 + 8 * fq : ckv + (unsigned)tok * 128 + (gi - 4) * 64 + 8 * fq;
          st8_bf16(dst, v[0]); st8_bf16(dst + 32, v[1]);
        } else if (gi == 6) {
          float* dst = kpe + (unsigned)tok * 32 + 8 * fq;
          *(f32x4*)dst = (f32x4){v[0][0], v[0][1], v[0][2], v[0][3]}; *(f32x4*)(dst + 4) = (f32x4){v[0][4], v[0][5], v[0][6], v[0][7]};
        } else if (gi < 17) {
          const bool isq = gi < 15; const float* gn = isq ? gq_norm : gk_norm;
          float ss = 0.f;
#pragma unroll
          for (int bj = 0; bj < 2; ++bj)
#pragma unroll
            for (int e = 0; e < 8; ++e) ss += v[bj][e] * v[bj][e];
          const float rn = rsqrtf(grp_sum(ss) * (1.f / 64.f) + EPS) * (isq ? 0.125f * LOG2E : 1.f);
          float kk = 0.f;
#pragma unroll
          for (int bj = 0; bj < 2; ++bj) {
            const unsigned ao = (unsigned)(bj == 0 ? (pos >> 6) : (pos & 63)) * 16 + 8 * (fq & 1);
            const f32x4 c0 = *(const f32x4*)(cos32 + ao), c1 = *(const f32x4*)(cos32 + ao + 4), s0 = *(const f32x4*)(sin32 + ao), s1 = *(const f32x4*)(sin32 + ao + 4);
#pragma unroll
            for (int e = 0; e < 8; ++e) {
              const float own = v[bj][e] * rn * gn[32 * bj + 8 * fq + e];
              const float oth = lane32_partner(own, lane);
              const float cc = e < 4 ? c0[e & 3] : c1[e & 3], sn = e < 4 ? s0[e & 3] : s1[e & 3];
              v[bj][e] = (fq < 2) ? own * cc - oth * sn : oth * sn + own * cc;
              kk += v[bj][e] * v[bj][e];
            }
          }
          bf16_t* dst = isq ? qd + ((unsigned)(bb * 8 + (gi - 7)) * S + pos) * 64 + 8 * fq : kd + ((unsigned)(bb * 2 + (gi - 15)) * S + pos) * 64 + 8 * fq;
          st8_bf16(dst, v[0]); st8_bf16(dst + 32, v[1]);
          if (!isq) kmx_run = fmaxf(kmx_run, grp_sum(kk));
        } else {
          bf16_t* dst = vtd + ((unsigned)(bb * 2 + (gi - 17)) * 64 + 8 * fq) * S + pos;
#pragma unroll
          for (int bj = 0; bj < 2; ++bj)
#pragma unroll
            for (int e = 0; e < 8; ++e) dst[(unsigned)(32 * bj + e) * S] = f2bf(v[bj][e]);
        }
        if (m & 1) asm volatile("" ::: "memory");
      }
    }
    if (gi == 15 || gi == 16) wave_atomic_max_pos(kmx_run, kmax2 + 32 + ((u.pm * 256) >> 13) * 2 + (gi - 15));
  }
};

template <int DQK, int DV>
__device__ __forceinline__ void attn_pass(const bf16_t* __restrict__ qh, const bf16_t* __restrict__ kh, const bf16_t* __restrict__ vth, int q0, char* smem, f32x16 (&o)[DV / 32], float kmax) {
  constexpr int KP = (DQK + 8) * 2, VP = 144, KSB = 64 * KP, VSB = DV * VP;
  constexpr int CK = DQK / 8, TKC = 64 * CK, NKC = (TKC + 511) / 512, NVC = DV / 64, NKS = DQK / 16, NEB = DV / 32, NT = S / 64;
  char* sK = smem; char* sV = smem + 2 * KSB;
  int tid = threadIdx.x; asm volatile("" : "+v"(tid));
  const int lane = tid & 63, wid = tid >> 6, r = lane & 31, h = lane >> 5;
  bf16x8 qf[NKS];
  {
    const bf16_t* qrow = qh + (size_t)(q0 + 32 * wid + r) * DQK + 8 * h;
#pragma unroll
    for (int ks = 0; ks < NKS; ++ks) qf[ks] = *(const bf16x8*)(qrow + 16 * ks);
  }
  int klo[NKC], vlo[NVC];
  const bf16_t* vg0 = vth + (size_t)(tid >> 3) * S + (tid & 7) * 8;
  const bool k1 = (TKC % 512 == 0) || (tid < TKC % 512);
#pragma unroll
  for (int j = 0; j < NKC; ++j) { const int c = tid + 512 * j; klo[j] = (c / CK) * KP + (c % CK) * 16; }
#pragma unroll
  for (int j = 0; j < NVC; ++j) { const int c = tid + 512 * j; vlo[j] = (c >> 3) * VP + (c & 7) * 16; }
  u32x4 rk[NKC], rv[NVC], rk1[NKC];
  const int rot = (int)((blockIdx.x >> 3) * 4u) & (NT - 1);
#define LOADK(dst, t) do { _Pragma("unroll") for (int j = 0; j < NKC; ++j) if (j == 0 || k1) dst[j] = *(const u32x4*)(kh + (size_t)(((t) + rot) & (NT - 1)) * 64 * DQK + (size_t)(tid + 512 * j) * 8); } while (0)
#define LOADV(dst, t) do { _Pragma("unroll") for (int j = 0; j < NVC; ++j) dst[j] = *(const u32x4*)(vg0 + (size_t)(64 * j) * S + (size_t)(((t) + rot) & (NT - 1)) * 64); } while (0)
#define STOREK(src, slot) do { _Pragma("unroll") for (int j = 0; j < NKC; ++j) if (j == 0 || k1) *(u32x4*)(sK + (slot) * KSB + klo[j]) = src[j]; } while (0)
#define STOREV(src, slot) do { _Pragma("unroll") for (int j = 0; j < NVC; ++j) *(u32x4*)(sV + (slot) * VSB + vlo[j]) = src[j]; } while (0)
  LOADK(rk, 0); LOADV(rv, 0); LOADK(rk1, 1);
#pragma unroll
  for (int eb = 0; eb < NEB; ++eb)
#pragma unroll
    for (int i = 0; i < 16; ++i) o[eb][i] = 0.f;
  float l_run = 0.f;
  f32x16 negm;
  {
    float qq = 0.f;
#pragma unroll
    for (int ks = 0; ks < NKS; ++ks)
#pragma unroll
      for (int j = 0; j < 8; ++j) { const float t = bf2f((unsigned short)qf[ks][j]); qq += t * t; }
    { auto rr = __builtin_amdgcn_permlane32_swap(__float_as_uint(qq), __float_as_uint(qq), false, false); qq = __uint_as_float(rr[0]) + __uint_as_float(rr[1]); }
    const float mref = sqrtf(qq) * kmax * 1.01f + 0.01f;
#pragma unroll
    for (int i = 0; i < 16; ++i) negm[i] = -mref;
  }
  __syncthreads();
  STOREK(rk, 0); STOREV(rv, 0); STOREK(rk1, 1);
  LOADK(rk, 2); LOADV(rv, 1);
  const int kofs = swz23(r) * KP + 16 * h, vofs = r * VP + 16 * h;
  __syncthreads();
  f32x16 sA, sB;
#define QKT(SD, slot) do { const char* kb0_ = sK + (slot) * KSB + kofs; \
    { const bf16x8 a0 = *(const bf16x8*)(kb0_), a1 = *(const bf16x8*)(kb0_ + 32 * KP); SD##0 = MFMA(a0, qf[0], negm); SD##1 = MFMA(a1, qf[0], negm); } \
    _Pragma("unroll") for (int ks = 1; ks < NKS; ++ks) { const bf16x8 a0 = *(const bf16x8*)(kb0_ + ks * 32), a1 = *(const bf16x8*)(kb0_ + 32 * KP + ks * 32); \
      SD##0 = MFMA(a0, qf[ks], SD##0); SD##1 = MFMA(a1, qf[ks], SD##1); } } while (0)
  f32x16 sA0, sA1, sB0, sB1;
  QKT(sA, 0);
#define STEP(SC, SN, t) do { \
    __syncthreads(); \
    if ((t) + 2 < NT) { STOREK(rk, (t) & 1); } \
    if ((t) + 1 < NT) { STOREV(rv, ((t) + 1) & 1); } \
    if ((t) + 3 < NT) { LOADK(rk, (t) + 3); } \
    if ((t) + 2 < NT) { LOADV(rv, (t) + 2); } \
    if ((t) + 1 < NT) { QKT(SN, ((t) + 1) & 1); } \
    float rsum0 = 0.f, rsum1 = 0.f; \
    _Pragma("unroll") for (int i = 0; i < 16; ++i) { SC##0[i] = fexp2(SC##0[i]); SC##1[i] = fexp2(SC##1[i]); rsum0 += SC##0[i]; rsum1 += SC##1[i]; } \
    l_run += rsum0 + rsum1; \
    bf16x8 pf[2][2]; \
    { u32x4 w; \
      w.x = pk2(SC##0[0], SC##0[1]); w.y = pk2(SC##0[2], SC##0[3]); w.z = pk2(SC##0[4], SC##0[5]); w.w = pk2(SC##0[6], SC##0[7]); pf[0][0] = __builtin_bit_cast(bf16x8, w); \
      w.x = pk2(SC##0[8], SC##0[9]); w.y = pk2(SC##0[10], SC##0[11]); w.z = pk2(SC##0[12], SC##0[13]); w.w = pk2(SC##0[14], SC##0[15]); pf[0][1] = __builtin_bit_cast(bf16x8, w); \
      w.x = pk2(SC##1[0], SC##1[1]); w.y = pk2(SC##1[2], SC##1[3]); w.z = pk2(SC##1[4], SC##1[5]); w.w = pk2(SC##1[6], SC##1[7]); pf[1][0] = __builtin_bit_cast(bf16x8, w); \
      w.x = pk2(SC##1[8], SC##1[9]); w.y = pk2(SC##1[10], SC##1[11]); w.z = pk2(SC##1[12], SC##1[13]); w.w = pk2(SC##1[14], SC##1[15]); pf[1][1] = __builtin_bit_cast(bf16x8, w); } \
    const char* vb0_ = sV + ((t) & 1) * VSB + vofs; \
    _Pragma("unroll") for (int kb = 0; kb < 2; ++kb) \
      _Pragma("unroll") for (int s2 = 0; s2 < 2; ++s2) \
        _Pragma("unroll") for (int eb = 0; eb < NEB; ++eb) { \
          const bf16x8 a = *(const bf16x8*)(vb0_ + eb * 32 * VP + (32 * kb + 16 * s2) * 2); \
          o[eb] = MFMA(a, pf[kb][s2], o[eb]); } \
  } while (0)
#pragma unroll
  for (int ks = 0; ks < NKS; ++ks) asm volatile("" :: "v"(qf[ks]));
  if (__builtin_amdgcn_readfirstlane(tid >> 6) >= 4) __builtin_amdgcn_s_setprio(1);
#pragma unroll 1
  for (int kt = 0; kt < NT; kt += 2) {
    STEP(sA, sB, kt);
    STEP(sB, sA, kt + 1);
  }
  __builtin_amdgcn_s_setprio(0);
#undef STEP
#undef QKT
#undef LOADK
#undef LOADV
#undef STOREK
#undef STOREV
  float ltot;
  { auto rr = __builtin_amdgcn_permlane32_swap(__float_as_uint(l_run), __float_as_uint(l_run), false, false); ltot = __uint_as_float(rr[0]) + __uint_as_float(rr[1]); }
  const float linv = frcp(ltot);
#pragma unroll
  for (int eb = 0; eb < NEB; ++eb)
#pragma unroll
    for (int i = 0; i < 16; ++i) o[eb][i] *= linv;
}

__device__ __forceinline__ void store_o64(bf16_t* dst, const f32x16 (&o)[2], int h) {
#pragma unroll
  for (int eb = 0; eb < 2; ++eb)
#pragma unroll
    for (int i4 = 0; i4 < 4; ++i4) { u32x2 w; w.x = pk2(o[eb][4 * i4], o[eb][4 * i4 + 1]); w.y = pk2(o[eb][4 * i4 + 2], o[eb][4 * i4 + 3]); *(u32x2*)(dst + 32 * eb + 8 * i4 + 4 * h) = w; }
}

__device__ __forceinline__ int srccol(int mapid, int b) {
  if (mapid >= 5) { const int pn = b >> 3, bj = (b >> 2) & 1, wc = b & 3; return srccol(mapid == 5 ? 0 : 2, 2 * (4 * pn + wc) + bj); }
  if (mapid == 0) return 32 * b;
  if (mapid == 1) { const int pn = b >> 3, w = b & 7; return ((w >> 2) ? 2816 : 0) + 128 * pn + 32 * (w & 3); }
  if (mapid == 2) { if (b < 13) return 32 * b; if (b == 13) return -1; if (b < 38) return 416 + 32 * (b - 14); return -1; }
  const int hd = b >> 2, sub = b & 3; return sub < 3 ? hd * 96 + 32 * sub : -1;
}
__device__ __forceinline__ unsigned pk2h(float lo, float hi) { typedef _Float16 h2_t __attribute__((ext_vector_type(2))); const h2_t v = {(_Float16)lo, (_Float16)hi}; return __builtin_bit_cast(unsigned, v); }
template <int KB, bool F16 = false>
__device__ __forceinline__ void conv_matrix(const float* __restrict__ src, int ldsrc, int K, bf16_t* __restrict__ dst, int nblk, int mapid, const float* __restrict__ gain, float* tile, int wb = -1, int wn = 0) {
  if (wb < 0) { wb = blockIdx.x; wn = gridDim.x; }
  const int kblks = K / KB, nunits = (nblk >> 1) * kblks; int tid = threadIdx.x; asm volatile("" : "+v"(tid));
#pragma unroll 1
  for (int u = wb; u < nunits; u += wn) {
    const int nb = u / kblks, kb = u % kblks;
    const int c = tid & 63, kr = tid >> 6;
    const int sc = srccol(mapid, nb * 2 + (c >> 5));
    float v[KB / 8];
    if (sc >= 0) {
      const float* sp = src + (size_t)(kb * KB + kr) * ldsrc + sc + (c & 31);
#pragma unroll
      for (int p = 0; p < KB / 8; ++p) v[p] = sp[(size_t)(p * 8) * ldsrc];
      if (gain) {
#pragma unroll
        for (int p = 0; p < KB / 8; ++p) v[p] *= gain[kb * KB + p * 8 + kr];
      }
    } else {
#pragma unroll
      for (int p = 0; p < KB / 8; ++p) v[p] = 0.f;
    }
    __syncthreads();
#pragma unroll
    for (int p = 0; p < KB / 8; ++p) tile[(p * 8 + kr) * 65 + c] = v[p];
    __syncthreads();
    const int nr = tid >> 3, kc = tid & 7;
#pragma unroll
    for (int q = 0; q < KB / 64; ++q) {
      const float* tp = tile + (q * 64 + kc * 8) * 65 + nr;
      u32x4 w;
      if constexpr (F16) { w.x = pk2h(tp[0], tp[65]); w.y = pk2h(tp[130], tp[195]); w.z = pk2h(tp[260], tp[325]); w.w = pk2h(tp[390], tp[455]); }
      else { w.x = pk2(tp[0], tp[65]); w.y = pk2(tp[130], tp[195]); w.z = pk2(tp[260], tp[325]); w.w = pk2(tp[390], tp[455]); }
      *(u32x4*)(dst + (size_t)(nb * 64 + nr) * K + kb * KB + q * 64 + kc * 8) = w;
    }
  }
}

#define XB_TMO      128
#define XB_XCNT(j)  (256  + 64 * (j))
#define XB_XSUB(j)  (1280 + 64 * (j))
#define XB_XGEN(j)  (2304 + 64 * (j))
#define XB_TOP      3328
#define XB_TOPGEN   3392
#define XCD_BAR_WORDS 3456
#define XB_SPIN_CAP (1u << 18)
#define LAS __attribute__((address_space(3)))
__device__ __forceinline__ unsigned xb_ld(unsigned* p)              { return __hip_atomic_load(p, __ATOMIC_RELAXED, __HIP_MEMORY_SCOPE_AGENT); }
__device__ __forceinline__ unsigned xb_add(unsigned* p, unsigned v) { return __hip_atomic_fetch_add(p, v, __ATOMIC_RELAXED, __HIP_MEMORY_SCOPE_AGENT); }
__device__ __forceinline__ unsigned xb_xcc_id() { return (unsigned)__builtin_amdgcn_s_getreg((3 << 11) | 20) & 0xFu; }
#define XB_SPIN(cond, bar) do { unsigned _sp = 0; while (cond) { __builtin_amdgcn_s_sleep(1); \
    if ((++_sp & 255u) == 0u) { if (xb_ld(&(bar)[XB_TMO])) break; if (_sp > XB_SPIN_CAP) { atomicAdd(&(bar)[XB_TMO], 1u); break; } } } } while (0)
struct XcdBarrier { unsigned* bar; unsigned x; volatile LAS unsigned* st; };
__device__ __forceinline__ XcdBarrier xcd_barrier_post(unsigned* bar, volatile LAS unsigned* st) {
    XcdBarrier b; b.bar = bar; b.x = xb_xcc_id(); b.st = st;
    if (threadIdx.x == 0) (void)xb_add(&bar[XB_XCNT(b.x)], 1u);
    return b;
}
__device__ __forceinline__ void xcd_barrier_complete(unsigned* bar, unsigned x, unsigned& nloc, unsigned& nx) {
    const unsigned G = gridDim.x * gridDim.y * gridDim.z;
    unsigned sum, cnt, mine, sp = 0u;
    for (;;) {
        sum = 0u; cnt = 0u; mine = 0u;
#pragma unroll
        for (unsigned j = 0; j < 16; ++j) { const unsigned c = xb_ld(&bar[XB_XCNT(j)]); sum += c; cnt += (c > 0u) ? 1u : 0u; mine = (j == x) ? c : mine; }
        if (sum == G) break;
        __builtin_amdgcn_s_sleep(1);
        if ((++sp & 255u) == 0u) { if (xb_ld(&bar[XB_TMO])) break; if (sp > XB_SPIN_CAP) { atomicAdd(&bar[XB_TMO], 1u); break; } }
    }
    nloc = mine > 0u ? mine : 1u; nx = cnt > 0u ? cnt : 1u;
}
__device__ __forceinline__ void xcd_barrier(const XcdBarrier& b) {
    asm volatile("s_waitcnt vmcnt(0)" ::: "memory");
    __syncthreads();
    if (threadIdx.x == 0) {
        unsigned* bar = b.bar;
        __builtin_amdgcn_s_waitcnt(0);
        unsigned nloc = b.st[0], nx = b.st[1];
        if (nloc == 0u) { xcd_barrier_complete(bar, b.x, nloc, nx); b.st[0] = nloc; b.st[1] = nx; }
        const unsigned old = xb_add(&bar[XB_XSUB(b.x)], 1u);
        const unsigned gen = old / nloc;
        if (old + 1u == (gen + 1u) * nloc) {
            __builtin_amdgcn_fence(__ATOMIC_RELEASE, "agent");
            asm volatile("s_waitcnt vmcnt(0)" ::: "memory");
            const unsigned og = xb_add(&bar[XB_TOP], 1u);
            const unsigned tg = og / nx;
            if (og + 1u == (tg + 1u) * nx) xb_add(&bar[XB_TOPGEN], 1u);
            else XB_SPIN(xb_ld(&bar[XB_TOPGEN]) == tg, bar);
            __builtin_amdgcn_fence(__ATOMIC_ACQUIRE, "agent");
            xb_add(&bar[XB_XGEN(b.x)], 1u);
            asm volatile("s_waitcnt vmcnt(0)" ::: "memory");
        } else {
            XB_SPIN(xb_ld(&bar[XB_XGEN(b.x)]) == gen, bar);
            __builtin_amdgcn_fence(__ATOMIC_ACQUIRE, "agent");
            asm volatile("s_waitcnt vmcnt(0)" ::: "memory");
        }
    }
    __syncthreads();
}

__global__ void __launch_bounds__(512, 2) mega_fwd(Params p_arg) {
  typedef const __attribute__((address_space(4))) Params* KParamsPtr;
  KParamsPtr pptr = (KParamsPtr)__builtin_amdgcn_kernarg_segment_ptr(); asm volatile("" : "+s"(pptr));
  const __attribute__((address_space(4))) Params& p = *pptr;
  __shared__ __attribute__((aligned(16))) char smem[147456 + 16];
  cg::grid_group grid = cg::this_grid();
  if (p.flags) grid.sync();
  if (threadIdx.x == 0) { *(volatile LAS unsigned*)(smem + 147456) = 0u; *(volatile LAS unsigned*)(smem + 147460) = 0u; }
  __syncthreads();
  const XcdBarrier xbar = xcd_barrier_post((unsigned*)(p.ws + O_CTL), (volatile LAS unsigned*)(smem + 147456));
  char* ws = p.ws;
  float* cos64 = (float*)(ws + O_COS64); float* sin64 = (float*)(ws + O_SIN64);
  float* cos32 = (float*)(ws + O_COS32); float* sin32 = (float*)(ws + O_SIN32);
  float* ssq = (float*)(ws + O_SSQ); float* ssq2 = (float*)(ws + O_SSQ2); float* kpe = (float*)(ws + O_KPE);
  bf16_t* xb = (bf16_t*)(ws + O_XB); bf16_t* hbuf = (bf16_t*)(ws + O_H); bf16_t* mix = (bf16_t*)p.out; _Float16* x16 = (_Float16*)(ws + O_X16);
  const int G = gridDim.x;

  {
    float* tile = (float*)smem;
    const bool defer = (G == 256);
    for (int l = 0; l < (defer ? 1 : 2); ++l) {
      conv_matrix<256, true>(p.ffn1_w_gu + (size_t)l * 1024 * 5632, 5632, 1024, (bf16_t*)(ws + O_WGU + (size_t)(2 * l) * SZ_WGU), 176, 1, p.ffn1_norm + l * 1024, tile);
      conv_matrix<256, true>(p.ffn2_w_gu + (size_t)l * 1024 * 5632, 5632, 1024, (bf16_t*)(ws + O_WGU + (size_t)(2 * l + 1) * SZ_WGU), 176, 1, p.ffn2_norm + l * 1024, tile);
      conv_matrix<256>(p.ffn1_w_down + (size_t)l * 2816 * 1024, 1024, 2816, (bf16_t*)(ws + O_WDN + (size_t)(2 * l) * SZ_WDN), 32, 0, nullptr, tile);
      conv_matrix<256>(p.ffn2_w_down + (size_t)l * 2816 * 1024, 1024, 2816, (bf16_t*)(ws + O_WDN + (size_t)(2 * l + 1) * SZ_WDN), 32, 0, nullptr, tile);
    }
    conv_matrix<256, true>(p.ev_w_in, 2560, 1024, (bf16_t*)(ws + O_WEVIN), 80, 5, p.ev_norm, tile);
    conv_matrix<256>(p.ev_w_out, 1024, 1024, (bf16_t*)(ws + O_WEVOUT), 32, 0, nullptr, tile);
    if (!defer) {
      conv_matrix<256, true>(p.od_w_in, 1184, 1024, (bf16_t*)(ws + O_WODIN), 40, 6, p.od_norm, tile);
      conv_matrix<256>(p.od_w_uq, 768, 256, (bf16_t*)(ws + O_WUQ), 32, 3, p.od_cq_norm, tile);
      conv_matrix<128>(p.od_w_ukv, 1024, 128, (bf16_t*)(ws + O_WUKV), 32, 0, p.od_ckv_norm, tile);
      conv_matrix<256>(p.od_w_out, 1024, 1024, (bf16_t*)(ws + O_WODOUT), 32, 0, nullptr, tile);
    }
    int tid = threadIdx.x; asm volatile("" : "+v"(tid));
    const int lane = tid & 63, wid = tid >> 6;
    const int gt = blockIdx.x * 512 + tid, nth = G * 512;
    { bf16_t* wss = (bf16_t*)(ws + O_WSS);
      for (int i = gt; i < 8 * 128 * 128 / 4; i += nth) { const f32x4 v = *(const f32x4*)(p.ev_w_s + (size_t)i * 4); u32x2 w; w.x = pk2(v[0], v[1]); w.y = pk2(v[2], v[3]); *(u32x2*)(wss + (size_t)i * 4) = w; } }
    for (int i = gt; i < 8192 * 32; i += nth) {
      const int pp = i >> 5, d = i & 31; const float inv = (float)exp2(-(double)d * (13.287712379549449 / 32.0)); const float ang = (float)pp * inv;
      cos64[i] = (float)cos((double)ang); sin64[i] = (float)sin((double)ang);
    }
    for (int i = gt; i < 8192 * 16; i += nth) {
      const int pp = i >> 4, d = i & 15; const float inv = (float)exp2(-(double)d * (13.287712379549449 / 16.0)); const float ang = (float)pp * inv;
      cos32[i] = (float)cos((double)ang); sin32[i] = (float)sin((double)ang);
    }
    for (int row = blockIdx.x * 8 + wid; row < T; row += G * 8) {
      const float* xr = p.x + (size_t)row * DM + lane * 16; float ss = 0.f; u32x4 w0, w1;
      const f32x4 a = *(const f32x4*)(xr), b = *(const f32x4*)(xr + 4), c = *(const f32x4*)(xr + 8), d = *(const f32x4*)(xr + 12);
      ss = (a[0] * a[0] + a[1] * a[1] + a[2] * a[2] + a[3] * a[3]) + (b[0] * b[0] + b[1] * b[1] + b[2] * b[2] + b[3] * b[3]) + (c[0] * c[0] + c[1] * c[1] + c[2] * c[2] + c[3] * c[3]) + (d[0] * d[0] + d[1] * d[1] + d[2] * d[2] + d[3] * d[3]);
      w0.x = pk2(a[0], a[1]); w0.y = pk2(a[2], a[3]); w0.z = pk2(b[0], b[1]); w0.w = pk2(b[2], b[3]);
      w1.x = pk2(c[0], c[1]); w1.y = pk2(c[2], c[3]); w1.z = pk2(d[0], d[1]); w1.w = pk2(d[2], d[3]);
      { typedef _Float16 h8_t __attribute__((ext_vector_type(8))); typedef float f8_t __attribute__((ext_vector_type(8)));
        const f8_t f0 = {a[0], a[1], a[2], a[3], b[0], b[1], b[2], b[3]}, f1 = {c[0], c[1], c[2], c[3], d[0], d[1], d[2], d[3]};
        *(h8_t*)(x16 + (size_t)row * DM + lane * 16) = __builtin_convertvector(f0, h8_t); *(h8_t*)(x16 + (size_t)row * DM + lane * 16 + 8) = __builtin_convertvector(f1, h8_t); }
      ss += __shfl_xor(ss, 1); ss += __shfl_xor(ss, 2);
      if ((lane & 3) == 0) ssq[(size_t)row * 16 + (lane >> 2)] = ss;
    }
  }
  xcd_barrier(xbar);

  auto layer_body = [&](auto LC) __attribute__((always_inline)) {
    constexpr int l = decltype(LC)::value;
    { pg8::Gemm g{(const bf16_t*)x16, (const bf16_t*)(ws + O_WGU + (size_t)(2 * l) * SZ_WGU), T, 5632, 1024}; pg8::StaticOrder so; so.init(T, 5632, (int)gridDim.x, (int)blockIdx.x); EpiGU8 e{ssq, hbuf};
      pg8::gemm_phase<EpiGU8, pg8::StaticOrder, true, true, true>((PG8_LAS unsigned char*)smem, g, so, e); }
    if constexpr (l == 0) {
      if (G == 256 && blockIdx.x >= 128) {
        float* tile = (float*)smem; const int wb = (int)blockIdx.x - 128;
        conv_matrix<256, true>(p.ffn1_w_gu + (size_t)1024 * 5632, 5632, 1024, (bf16_t*)(ws + O_WGU + (size_t)2 * SZ_WGU), 176, 1, p.ffn1_norm + 1024, tile, wb, 128);
        conv_matrix<256>(p.ffn1_w_down + (size_t)2816 * 1024, 1024, 2816, (bf16_t*)(ws + O_WDN + (size_t)2 * SZ_WDN), 32, 0, nullptr, tile, wb, 128);
        conv_matrix<256, true>(p.od_w_in, 1184, 1024, (bf16_t*)(ws + O_WODIN), 40, 6, p.od_norm, tile, wb, 128);
        conv_matrix<256>(p.od_w_uq, 768, 256, (bf16_t*)(ws + O_WUQ), 32, 3, p.od_cq_norm, tile, wb, 128);
        conv_matrix<128>(p.od_w_ukv, 1024, 128, (bf16_t*)(ws + O_WUKV), 32, 0, p.od_ckv_norm, tile, wb, 128);
      }
    }
    xcd_barrier(xbar);
    { pg8::Gemm g{hbuf, (const bf16_t*)(ws + O_WDN + (size_t)(2 * l) * SZ_WDN), T, 1024, 2816}; pg8::StaticOrder so; so.init(T, 1024, (int)gridDim.x, (int)blockIdx.x); EpiRes8 e{x16, p.out, xb, ssq, 0.5f, 1};
      pg8::gemm_phase<EpiRes8, pg8::StaticOrder, false, true>((PG8_LAS unsigned char*)smem, g, so, e); }
    xcd_barrier(xbar);
    if constexpr (l == 0) {
      bf16_t* ub = (bf16_t*)(ws + O_U); bf16_t* vt = (bf16_t*)(ws + O_VT); bf16_t* qb = (bf16_t*)(ws + O_QB); bf16_t* kb = (bf16_t*)(ws + O_KB); bf16_t* vtb = (bf16_t*)(ws + O_VTB);
      { pg8::Gemm g{(const bf16_t*)x16, (const bf16_t*)(ws + O_WEVIN), T, 2560, 1024}; pg8::StaticOrder so; so.init(T, 2560, (int)gridDim.x, (int)blockIdx.x);
        EpiEvIn8 e{ssq, p.ev_sgu_norm, p.ev_q_norm, p.ev_k_norm, cos64, sin64, ub, vt, qb, kb, vtb, (unsigned*)(ws + O_KMAX)};
        pg8::gemm_phase<EpiEvIn8, pg8::StaticOrder, true, true, true>((PG8_LAS unsigned char*)smem, g, so, e); }
      xcd_barrier(xbar);
      { EpiGmlp e{p.ev_b_s, ub, mix}; gemm_phase<false, 1>((const bf16_t*)(ws + O_WSS), 128, 1, vt, 128, 128, smem, e); }
      {
        float d1 = 0.f, d2 = 0.f;
        for (int i = 0; i < 64; ++i) { d1 += p.ev_lam_q1[i] * p.ev_lam_k1[i]; d2 += p.ev_lam_q2[i] * p.ev_lam_k2[i]; }
        const float lam_init = 0.2f, lam = expf(d1) - expf(d2) + lam_init;
        int tid = threadIdx.x; asm volatile("" : "+v"(tid));
        const int lane = tid & 63, wid = tid >> 6, r = lane & 31, h = lane >> 5;
        const unsigned* kmx = (const unsigned*)(ws + O_KMAX);
#pragma unroll 1
        for (int u = blockIdx.x; u < 256; u += G) {
          const int bh = u & 7, qt = u >> 3, bb = bh >> 2, hd = bh & 3;
          const bf16_t* vth = vtb + (size_t)(bb * 4 + hd) * 128 * S;
          f32x16 o[4];
          const int tok = bb * S + qt * 256 + 32 * wid + r;
          bf16_t* dst = mix + (size_t)tok * DM + 512 + hd * 128;
          attn_pass<64, 128>(qb + (size_t)(bb * 8 + hd * 2) * S * 64, kb + (size_t)(bb * 8 + hd * 2) * S * 64, vth, qt * 256, smem, o, kmax_of(kmx, bb * 8 + hd * 2));
#pragma unroll
          for (int eb = 0; eb < 4; ++eb)
#pragma unroll
            for (int i4 = 0; i4 < 4; ++i4) { u32x2 w; w.x = pk2(o[eb][4 * i4], o[eb][4 * i4 + 1]); w.y = pk2(o[eb][4 * i4 + 2], o[eb][4 * i4 + 3]); *(u32x2*)(dst + 32 * eb + 8 * i4 + 4 * h) = w; }
          attn_pass<64, 128>(qb + (size_t)(bb * 8 + hd * 2 + 1) * S * 64, kb + (size_t)(bb * 8 + hd * 2 + 1) * S * 64, vth, qt * 256, smem, o, kmax_of(kmx, bb * 8 + hd * 2 + 1));
          float ss = 0.f;
#pragma unroll
          for (int eb = 0; eb < 4; ++eb)
#pragma unroll
            for (int i4 = 0; i4 < 4; ++i4) {
              const u32x2 w = *(const volatile u32x2*)(dst + 32 * eb + 8 * i4 + 4 * h);
              const float a0 = __builtin_bit_cast(float, w.x << 16), a1 = __builtin_bit_cast(float, w.x & 0xffff0000u);
              const float a2 = __builtin_bit_cast(float, w.y << 16), a3 = __builtin_bit_cast(float, w.y & 0xffff0000u);
              o[eb][4 * i4] = a0 - lam * o[eb][4 * i4]; o[eb][4 * i4 + 1] = a1 - lam * o[eb][4 * i4 + 1];
              o[eb][4 * i4 + 2] = a2 - lam * o[eb][4 * i4 + 2]; o[eb][4 * i4 + 3] = a3 - lam * o[eb][4 * i4 + 3];
              ss += (o[eb][4 * i4] * o[eb][4 * i4] + o[eb][4 * i4 + 1] * o[eb][4 * i4 + 1]) + (o[eb][4 * i4 + 2] * o[eb][4 * i4 + 2] + o[eb][4 * i4 + 3] * o[eb][4 * i4 + 3]);
            }
          ss += __shfl_xor(ss, 32);
          const float rn = rsqrtf(ss * (1.f / 128.f) + EPS) * (1.f - lam_init);
#pragma unroll
          for (int eb = 0; eb < 4; ++eb)
#pragma unroll
            for (int i4 = 0; i4 < 4; ++i4) {
              float v[4];
#pragma unroll
              for (int c = 0; c < 4; ++c) v[c] = o[eb][4 * i4 + c] * rn * p.ev_sub_norm[32 * eb + 8 * i4 + 4 * h + c];
              u32x2 w; w.x = pk2(v[0], v[1]); w.y = pk2(v[2], v[3]);
              *(u32x2*)(dst + 32 * eb + 8 * i4 + 4 * h) = w;
            }
        }
      }
      xcd_barrier(xbar);
      { pg8::Gemm g{mix, (const bf16_t*)(ws + O_WEVOUT), T, 1024, 1024}; pg8::StaticOrder so; so.init(T, 1024, (int)gridDim.x, (int)blockIdx.x); EpiRes8 e{x16, p.out, xb, ssq, 1.0f, 1};
        pg8::gemm_phase<EpiRes8, pg8::StaticOrder, false, true>((PG8_LAS unsigned char*)smem, g, so, e); }
      xcd_barrier(xbar);
    } else {
      bf16_t* cq = (bf16_t*)(ws + O_CQ); bf16_t* ckv = (bf16_t*)(ws + O_CKV); bf16_t* qc = (bf16_t*)(ws + O_QC); bf16_t* kc = (bf16_t*)(ws + O_KC);
      bf16_t* vtc = (bf16_t*)(ws + O_VTC); bf16_t* qd = (bf16_t*)(ws + O_QD); bf16_t* kd = (bf16_t*)(ws + O_KD); bf16_t* vtd = (bf16_t*)(ws + O_VTD);
      { pg8::Gemm g{(const bf16_t*)x16, (const bf16_t*)(ws + O_WODIN), T, 1280, 1024}; pg8::StaticOrder so; so.init(T, 1280, (int)gridDim.x, (int)blockIdx.x);
        EpiOdIn8 e{ssq, p.od_gqa_q_norm, p.od_gqa_k_norm, cos32, sin32, cq, ckv, ssq2, kpe, qd, kd, vtd, (unsigned*)(ws + O_KMAX)};
        pg8::gemm_phase<EpiOdIn8, pg8::StaticOrder, true, true, true, true>((PG8_LAS unsigned char*)smem, g, so, e); }
      xcd_barrier(xbar);
      { EpiUq e{ssq2, p.od_mla_q_norm, cos32, sin32, qc}; gemm_phase<true, 0>((const bf16_t*)(ws + O_WUQ), 256, 4, cq, 256, 256, smem, e); }
      { EpiUkv e{ssq2, p.od_mla_k_norm, kpe, cos32, sin32, kc, vtc, (unsigned*)(ws + O_KMAX)}; gemm_phase<false, 0>((const bf16_t*)(ws + O_WUKV), 128, 4, ckv, 128, 128, smem, e); }
      xcd_barrier(xbar);
      {
        int tid = threadIdx.x; asm volatile("" : "+v"(tid));
        const int lane = tid & 63, wid = tid >> 6, r = lane & 31, h = lane >> 5;
        const unsigned* kmx = (const unsigned*)(ws + O_KMAX);
#pragma unroll 1
        for (int u = blockIdx.x; u < 1024; u += G) {
          f32x16 o[2];
          const int uu = u & 511, bh = uu & 15, qt = uu >> 4, bb = bh >> 3, hh = bh & 7;
          const int tok = bb * S + qt * 256 + 32 * wid + r;
          if (u < 512) {
            attn_pass<96, 64>(qc + (size_t)(bb * 8 + hh) * S * 96, kc + (size_t)(bb * 8 + hh) * S * 96, vtc + (size_t)(bb * 8 + hh) * 64 * S, qt * 256, smem, o, kmax_of(kmx, 16 + bb * 8 + hh));
            store_o64(mix + (size_t)tok * DM + hh * 64, o, h);
          } else {
            const int kvh = hh >> 2;
            attn_pass<64, 64>(qd + (size_t)(bb * 8 + hh) * S * 64, kd + (size_t)(bb * 2 + kvh) * S * 64, vtd + (size_t)(bb * 2 + kvh) * 64 * S, qt * 256, smem, o, kmax_of(kmx, 32 + bb * 2 + kvh));
            store_o64(mix + (size_t)tok * DM + 512 + hh * 64, o, h);
          }
        }
      }
      xcd_barrier(xbar);
      { pg8::Gemm g{mix, (const bf16_t*)(ws + O_WODOUT), T, 1024, 1024}; pg8::StaticOrder so; so.init(T, 1024, (int)gridDim.x, (int)blockIdx.x); EpiRes8 e{x16, p.out, xb, ssq, 1.0f, 1};
        pg8::gemm_phase<EpiRes8, pg8::StaticOrder, false, true>((PG8_LAS unsigned char*)smem, g, so, e); }
      xcd_barrier(xbar);
    }
    { pg8::Gemm g{(const bf16_t*)x16, (const bf16_t*)(ws + O_WGU + (size_t)(2 * l + 1) * SZ_WGU), T, 5632, 1024}; pg8::StaticOrder so; so.init(T, 5632, (int)gridDim.x, (int)blockIdx.x); EpiGU8 e{ssq, hbuf};
      pg8::gemm_phase<EpiGU8, pg8::StaticOrder, true, true, true>((PG8_LAS unsigned char*)smem, g, so, e); }
    if constexpr (l == 0) {
      if (G == 256 && blockIdx.x >= 128) {
        float* tile = (float*)smem; const int wb = (int)blockIdx.x - 128;
        conv_matrix<256, true>(p.ffn2_w_gu + (size_t)1024 * 5632, 5632, 1024, (bf16_t*)(ws + O_WGU + (size_t)3 * SZ_WGU), 176, 1, p.ffn2_norm + 1024, tile, wb, 128);
        conv_matrix<256>(p.ffn2_w_down + (size_t)2816 * 1024, 1024, 2816, (bf16_t*)(ws + O_WDN + (size_t)3 * SZ_WDN), 32, 0, nullptr, tile, wb, 128);
        conv_matrix<256>(p.od_w_out, 1024, 1024, (bf16_t*)(ws + O_WODOUT), 32, 0, nullptr, tile, wb, 128);
      }
    }
    xcd_barrier(xbar);
    { pg8::Gemm g{hbuf, (const bf16_t*)(ws + O_WDN + (size_t)(2 * l + 1) * SZ_WDN), T, 1024, 2816}; pg8::StaticOrder so; so.init(T, 1024, (int)gridDim.x, (int)blockIdx.x); EpiRes8 e{x16, p.out, xb, ssq, 0.5f, l == 0 ? 1 : 0};
      pg8::gemm_phase<EpiRes8, pg8::StaticOrder, false, true>((PG8_LAS unsigned char*)smem, g, so, e); }
    if (l == 0) xcd_barrier(xbar);
  };
  layer_body(std::integral_constant<int, 0>{});
  layer_body(std::integral_constant<int, 1>{});
}

extern "C" void kernel_launch(void* const* d_in, const int* in_sizes, int n_in, void* d_out, int out_size, void* d_ws, size_t ws_size, hipStream_t stream) {
  static int grid_blocks = 0;
  if (!grid_blocks) {
    int dev = 0, cus = 0, per_cu = 0;
    hipGetDevice(&dev);
    hipDeviceGetAttribute(&cus, hipDeviceAttributeMultiprocessorCount, dev);
    hipOccupancyMaxActiveBlocksPerMultiprocessor(&per_cu, mega_fwd, 512, 0);
    if (per_cu > 1) per_cu = 1;
    if (per_cu < 1) per_cu = 1;
    grid_blocks = cus * per_cu;
  }
  Params p{};
  const float** pp = (const float**)&p;
  for (int i = 0; i < 31; ++i) pp[i] = (const float*)d_in[i];
  p.out = (float*)d_out; p.ws = (char*)d_ws;
  hipMemsetAsync(d_ws, 0, 16384, stream);
  void* args[] = {&p};
  hipError_t e = hipLaunchCooperativeKernel((void*)mega_fwd, dim3(grid_blocks), dim3(512), args, 0, stream);
  if (e != hipSuccess) fprintf(stderr, "cooperative launch failed: %s (grid %d)\n", hipGetErrorString(e), grid_blocks);
}
```

```cpp
#include <hip/hip_runtime.h>
#include <hip/hip_cooperative_groups.h>
#include <stdint.h>
#include <stdio.h>
#include <type_traits>
namespace cg = cooperative_groups;

typedef unsigned short bf16_t;
typedef __attribute__((ext_vector_type(8))) short bf16x8;
typedef __attribute__((ext_vector_type(16))) float f32x16;
typedef __attribute__((ext_vector_type(4))) float f32x4;
typedef __attribute__((ext_vector_type(4))) unsigned u32x4;
typedef __attribute__((ext_vector_type(2))) unsigned u32x2;
typedef float f32x2_t __attribute__((ext_vector_type(2)));
typedef __bf16 bf16x2_t __attribute__((ext_vector_type(2)));

constexpr int T = 16384, S = 8192, DM = 1024, DFF = 2816;
constexpr float EPS = 1e-6f;
constexpr float LOG2E = 1.4426950408889634f;

constexpr size_t O_CTL = 0;
constexpr size_t O_COS64 = 16384;
constexpr size_t O_SIN64 = O_COS64 + (size_t)8192 * 32 * 4;
constexpr size_t O_COS32 = O_SIN64 + (size_t)8192 * 32 * 4;
constexpr size_t O_SIN32 = O_COS32 + (size_t)8192 * 16 * 4;
constexpr size_t O_SSQ = O_SIN32 + (size_t)8192 * 16 * 4;
constexpr size_t O_SSQ2 = O_SSQ + (size_t)T * 16 * 4;
constexpr size_t O_KPE = O_SSQ2 + (size_t)T * 8 * 4;
constexpr size_t O_WGU = O_KPE + (size_t)T * 32 * 4;
constexpr size_t SZ_WGU = (size_t)5632 * 1024 * 2;
constexpr size_t O_WDN = O_WGU + 4 * SZ_WGU;
constexpr size_t SZ_WDN = (size_t)1024 * 2816 * 2;
constexpr size_t O_WEVIN = O_WDN + 4 * SZ_WDN;
constexpr size_t O_WEVOUT = O_WEVIN + (size_t)2560 * 1024 * 2;
constexpr size_t O_WODIN = O_WEVOUT + (size_t)1024 * 1024 * 2;
constexpr size_t O_WUQ = O_WODIN + (size_t)1280 * 1024 * 2;
constexpr size_t O_WUKV = O_WUQ + (size_t)1024 * 256 * 2;
constexpr size_t O_WODOUT = O_WUKV + (size_t)1024 * 128 * 2;
constexpr size_t O_WSS = O_WODOUT + (size_t)1024 * 1024 * 2;
constexpr size_t O_XB = O_WSS + (size_t)8 * 128 * 128 * 2;
constexpr size_t O_X16 = O_XB + (size_t)T * 1024 * 2;
constexpr size_t O_BIG = O_X16 + (size_t)T * 1024 * 2;
constexpr size_t O_H = O_BIG;
constexpr size_t O_M1 = O_BIG;
constexpr size_t O_U = O_M1;
constexpr size_t O_VT = O_U + (size_t)T * 512 * 2;
constexpr size_t O_QB = O_VT + (size_t)T * 512 * 2;
constexpr size_t O_KB = O_QB + (size_t)T * 512 * 2;
constexpr size_t O_VTB = O_KB + (size_t)T * 512 * 2;
constexpr size_t O_EV_END = O_VTB + (size_t)T * 512 * 2;
constexpr size_t O_CQ = O_M1;
constexpr size_t O_CKV = O_CQ + (size_t)T * 256 * 2;
constexpr size_t O_QC = O_CKV + (size_t)T * 128 * 2;
constexpr size_t O_KC = O_QC + (size_t)T * 8 * 96 * 2;
constexpr size_t O_VTC = O_KC + (size_t)T * 8 * 96 * 2;
constexpr size_t O_QD = O_VTC + (size_t)T * 512 * 2;
constexpr size_t O_KD = O_QD + (size_t)T * 512 * 2;
constexpr size_t O_VTD = O_KD + (size_t)T * 128 * 2;
constexpr size_t O_OD_END = O_VTD + (size_t)T * 128 * 2;
constexpr size_t O_H_END = O_H + (size_t)T * DFF * 2;
static_assert(O_OD_END <= ((size_t)256 << 20) && O_EV_END <= ((size_t)256 << 20) && O_H_END <= ((size_t)256 << 20), "ws map");

struct Params {
  const float* x; const float* ffn1_norm; const float* ffn1_w_gu; const float* ffn1_w_down;
  const float* ffn2_norm; const float* ffn2_w_gu; const float* ffn2_w_down;
  const float* ev_norm; const float* ev_w_in; const float* ev_sgu_norm; const float* ev_w_s; const float* ev_b_s;
  const float* ev_q_norm; const float* ev_k_norm; const float* ev_lam_q1; const float* ev_lam_k1; const float* ev_lam_q2; const float* ev_lam_k2;
  const float* ev_sub_norm; const float* ev_w_out;
  const float* od_norm; const float* od_w_in; const float* od_cq_norm; const float* od_ckv_norm; const float* od_w_uq; const float* od_w_ukv;
  const float* od_mla_q_norm; const float* od_mla_k_norm; const float* od_gqa_q_norm; const float* od_gqa_k_norm; const float* od_w_out;
  float* out; char* ws; int flags; int pad;
};

__device__ __forceinline__ unsigned pk2(float lo, float hi) { f32x2_t v = {lo, hi}; bf16x2_t b = __builtin_convertvector(v, bf16x2_t); return __builtin_bit_cast(unsigned, b); }
__device__ __forceinline__ bf16_t f2bf(float f) { return (bf16_t)(pk2(f, 0.f) & 0xffffu); }
__device__ __forceinline__ float fexp2(float x) { return __builtin_amdgcn_exp2f(x); }
__device__ __forceinline__ float frcp(float x) { return __builtin_amdgcn_rcpf(x); }
__device__ __forceinline__ float sigm(float x) { return frcp(1.f + fexp2(-LOG2E * x)); }
__device__ __forceinline__ float gelu_tanh(float x) { const float y = 0.7978845608028654f * (x + 0.044715f * x * x * x); return x * sigm(2.f * y); }
__device__ __forceinline__ float bf2f(unsigned short b) { return __builtin_bit_cast(float, (unsigned)b << 16); }
__device__ __forceinline__ int swz23(int r) { return (r & ~12) | ((r & 4) << 1) | ((r & 8) >> 1); }
__device__ __forceinline__ float rstd16(const float* __restrict__ ssq, int tok) {
  const f32x4* p = (const f32x4*)(ssq + (size_t)tok * 16);
  const f32x4 a = p[0], b = p[1], c = p[2], d = p[3];
  const float s = ((a[0] + a[1]) + (a[2] + a[3])) + ((b[0] + b[1]) + (b[2] + b[3])) + ((c[0] + c[1]) + (c[2] + c[3])) + ((d[0] + d[1]) + (d[2] + d[3]));
  return rsqrtf(s * (1.f / 1024.f) + EPS);
}
#define MFMA(a, b, c) __builtin_amdgcn_mfma_f32_32x32x16_bf16((a), (b), (c), 0, 0, 0)

namespace pg8 {
#define PG8_LAS __attribute__((address_space(3)))
typedef unsigned short bf16_t;
typedef short bf16x8 __attribute__((ext_vector_type(8)));
typedef float f32x4 __attribute__((ext_vector_type(4)));
typedef unsigned u32x4 __attribute__((ext_vector_type(4)));
constexpr int BM = 256, BK = 64, HALF = 128, HTB = HALF * BK * 2  , STAGE_BYTES = 8 * HTB, NXCD = 8, WGM = 8;

__host__ __device__ __forceinline__ int lds_byte(int r, int c) { const int st = (r >> 4) * 2 + (c >> 5), rr = r & 15, cc = c & 31, ob = rr * 64 + cc * 2; return st * 1024 + (ob ^ (((ob >> 9) & 1) << 5)); }
__host__ __device__ __forceinline__ void stage_rc(int b, int& R, int& C) { const int st = b / 1024, sb = b % 1024, swz = sb ^ (((sb >> 9) & 1) << 5); R = (st >> 1) * 16 + swz / 64; C = (st & 1) * 32 + (swz % 64) / 2; }
__host__ __device__ __forceinline__ int perm32(int rho) { const int n = rho >> 4, i = rho & 15; return 8 * (i >> 2) + 4 * n + (i & 3); }

struct Unit { int pm, pn; };
struct Gemm { const bf16_t* A; const bf16_t* Bt; int M, N, K; };

struct StaticOrder {
    int nM, nN, nwg, G, c;
    __host__ __device__ void init(int M, int N, int G_, int c_) { nM = M / BM; nN = N / BM; nwg = nM * nN; G = G_; c = c_; }
    __host__ __device__ bool next(int i, Unit& u) const {
        const long L = (long)i * G + c; if (L >= nwg) return false;
        int wgid = (int)L; { const int q = nwg / NXCD, r = nwg % NXCD, xcd = wgid % NXCD, off = wgid / NXCD; wgid = (xcd < r ? xcd * (q + 1) : r * (q + 1) + (xcd - r) * q) + off; }
        const int nig = WGM * nN, gid = wgid / nig, fm = gid * WGM, gsz = (nM - fm) < WGM ? (nM - fm) : WGM;
        u.pm = fm + ((wgid % nig) % gsz); u.pn = (wgid % nig) / gsz; return true;
    }
    __device__ __forceinline__ void a_ready(const Unit&) const {}
    __device__ __forceinline__ void done(const Unit&) const {}
};
__device__ __forceinline__ unsigned cvt_pk_bf16(float lo, float hi) { unsigned r; asm volatile("v_cvt_pk_bf16_f32 %0, %1, %2" : "=v"(r) : "v"(lo), "v"(hi)); return r; }
typedef _Float16 f16x8 __attribute__((ext_vector_type(8)));
template <bool F16> __device__ __forceinline__ f32x4 mma16(bf16x8 b, bf16x8 a, f32x4 c) {
    if constexpr (F16) return __builtin_amdgcn_mfma_f32_16x16x32_f16(__builtin_bit_cast(f16x8, b), __builtin_bit_cast(f16x8, a), c, 0, 0, 0);
    else return __builtin_amdgcn_mfma_f32_16x16x32_bf16(b, a, c, 0, 0, 0);
}
template <class Epi, class Sched, bool ALIGN_EPI = false, bool SP2 = false, bool F16 = false, bool TOKPERM = false>
__device__ __forceinline__ void gemm_phase(PG8_LAS unsigned char* lds, const Gemm g, const Sched& S, const Epi& E) {
    int tid_ = threadIdx.x; asm volatile("" : "+v"(tid_));
    const int tid = tid_, wid = __builtin_amdgcn_readfirstlane(tid >> 6), lane = tid & 63, wr = wid >> 2, wc = wid & 3, fr = lane & 15, fq = lane >> 4;
    const int K = g.K, nt = K / BK;
    unsigned voffA[2], voffB[2];
#pragma unroll
    for (int i = 0; i < 2; ++i) { int R, C; stage_rc(tid * 16 + i * 8192, R, C); const int Rb = Epi::PERM ? ((R & ~31) + perm32(R & 31)) : R;
        const int Ra = TOKPERM ? ((R & ~63) + 4 * (R & 15) + ((R >> 4) & 3)) : R;
        voffA[i] = (unsigned)(Ra * K + C) * 2u; voffB[i] = (unsigned)(Rb * K + C) * 2u; }
    const size_t kstep = (size_t)(BK * 2);
    const size_t hstep = (size_t)HALF * K * 2;
    const size_t tstep = 2 * hstep;
    const unsigned ldsw = (unsigned)wid * 1024u;
    const int aoff = lds_byte(wr * 64 + fr, fq * 8), boff = lds_byte(wc * 32 + fr, fq * 8);
#define PG8_SA(b, h) (((b) * 2 + (h)) * HTB)
#define PG8_SB(b, h) ((4 + (b) * 2 + (h)) * HTB)
#define PG8_STAGE(bufoff, gbase, voff) do { _Pragma("unroll") for (int _i = 0; _i < 2; ++_i) \
        __builtin_amdgcn_global_load_lds((const unsigned*)((const char*)(gbase) + (voff)[_i]), (PG8_LAS unsigned*)(lds + (bufoff) + ldsw + _i * 8192), 16, 0, 0); } while (0)
#define PG8_LDA(dst, b, h) do { _Pragma("unroll") for (int m = 0; m < 4; ++m) _Pragma("unroll") for (int k = 0; k < 2; ++k) dst[m][k] = *(const PG8_LAS bf16x8*)(lds + PG8_SA(b, h) + aoff + m * 2048 + k * 1024); } while (0)
#define PG8_LDB(dst, b, h) do { _Pragma("unroll") for (int n = 0; n < 2; ++n) _Pragma("unroll") for (int k = 0; k < 2; ++k) dst[n][k] = *(const PG8_LAS bf16x8*)(lds + PG8_SB(b, h) + boff + n * 2048 + k * 1024); } while (0)
#define PG8_MMA(ai, bj, At, Bt) do { __builtin_amdgcn_s_setprio(1); _Pragma("unroll") for (int m = 0; m < 4; ++m) _Pragma("unroll") for (int n = 0; n < 2; ++n) _Pragma("unroll") for (int k = 0; k < 2; ++k) \
        acc[ai][bj][m][n] = mma16<F16>(Bt[n][k], At[m][k], acc[ai][bj][m][n]); __builtin_amdgcn_s_setprio(0); } while (0)
#define PG8_WAIT_V(n) asm volatile("s_waitcnt vmcnt(" #n ")" ::: "memory")
#define PG8_WAIT_L(n) asm volatile("s_waitcnt lgkmcnt(" #n ")" ::: "memory")
#define PG8_BAR __builtin_amdgcn_s_barrier()
#define PG8_SCHED __builtin_amdgcn_sched_barrier(0)
    Unit cur, nxt; int ui = 0;
    if (!S.next(0, cur)) return;
    f32x4 acc[2][2][4][2];
#pragma unroll
    for (int a = 0; a < 2; ++a)
#pragma unroll
        for (int b = 0; b < 2; ++b)
#pragma unroll
            for (int m = 0; m < 4; ++m)
#pragma unroll
                for (int n = 0; n < 2; ++n) acc[a][b][m][n] = (f32x4){0.f, 0.f, 0.f, 0.f};
    bf16x8 At[4][2], B0[2][2], B1[2][2];
    const char* cA = (const char*)g.A + (size_t)cur.pm * tstep; const char* cB = (const char*)g.Bt + (size_t)cur.pn * tstep;
    S.a_ready(cur);
    if constexpr (SP2) {
        PG8_STAGE(PG8_SB(0, 0), cB, voffB); PG8_STAGE(PG8_SB(0, 1), cB + hstep, voffB); PG8_STAGE(PG8_SA(0, 0), cA, voffA); PG8_STAGE(PG8_SA(0, 1), cA + hstep, voffA);
        if (wr == 1) PG8_BAR;
        PG8_WAIT_V(2); PG8_BAR;
        PG8_STAGE(PG8_SB(1, 0), cB + kstep, voffB); PG8_STAGE(PG8_SA(1, 0), cA + kstep, voffA); PG8_STAGE(PG8_SB(1, 1), cB + hstep + kstep, voffB);
        PG8_WAIT_V(6); PG8_BAR;
    } else {
        PG8_STAGE(PG8_SB(0, 0), cB, voffB); PG8_STAGE(PG8_SA(0, 0), cA, voffA); PG8_STAGE(PG8_SB(0, 1), cB + hstep, voffB); PG8_STAGE(PG8_SA(0, 1), cA + hstep, voffA);
        if (wr == 1) PG8_BAR;
        PG8_WAIT_V(4); PG8_BAR;
        PG8_STAGE(PG8_SB(1, 0), cB + kstep, voffB); PG8_STAGE(PG8_SA(1, 0), cA + kstep, voffA); PG8_STAGE(PG8_SB(1, 1), cB + hstep + kstep, voffB);
        PG8_WAIT_V(6); PG8_BAR;
    }
    for (;;) {
        const bool has_next = S.next(ui + 1, nxt);
        const char* nA = has_next ? (const char*)g.A + (size_t)nxt.pm * tstep : cA; const char* nB = has_next ? (const char*)g.Bt + (size_t)nxt.pn * tstep : cB;
        for (int t = 0; t < nt; t += 2) {
            const bool last = (t == nt - 2);
            const char* a1 = cA + (size_t)(t + 1) * kstep;
            const char* a2 = last ? nA : cA + (size_t)(t + 2) * kstep; const char* b2 = last ? nB : cB + (size_t)(t + 2) * kstep;
            const char* a3 = a2 + kstep; const char* b3 = b2 + kstep;
            if (last && has_next) S.a_ready(nxt);
            if constexpr (SP2) {
            PG8_LDB(B0, 0, 0); PG8_LDB(B1, 0, 1); PG8_SCHED; PG8_LDA(At, 0, 0); PG8_STAGE(PG8_SA(1, 1), a1 + hstep, voffA);
            PG8_WAIT_V(8); PG8_WAIT_L(0); PG8_BAR; PG8_MMA(0, 0, At, B0); PG8_MMA(0, 1, At, B1); PG8_BAR; PG8_SCHED;
            PG8_LDA(At, 0, 1); PG8_STAGE(PG8_SB(0, 0), b2, voffB); PG8_STAGE(PG8_SB(0, 1), b2 + hstep, voffB); PG8_STAGE(PG8_SA(0, 0), a2, voffA);
            PG8_WAIT_V(8); PG8_WAIT_L(0); PG8_BAR; PG8_MMA(1, 0, At, B0); PG8_MMA(1, 1, At, B1); PG8_BAR; PG8_SCHED;
            PG8_LDB(B0, 1, 0); PG8_LDB(B1, 1, 1); PG8_SCHED; PG8_LDA(At, 1, 0); PG8_STAGE(PG8_SA(0, 1), a2 + hstep, voffA);
            PG8_WAIT_V(8); PG8_WAIT_L(0); PG8_BAR; PG8_MMA(0, 0, At, B0); PG8_MMA(0, 1, At, B1); PG8_BAR; PG8_SCHED;
            PG8_LDA(At, 1, 1); PG8_STAGE(PG8_SB(1, 0), b3, voffB); PG8_STAGE(PG8_SB(1, 1), b3 + hstep, voffB); PG8_STAGE(PG8_SA(1, 0), a3, voffA);
            PG8_WAIT_V(8); PG8_WAIT_L(0); PG8_BAR; PG8_MMA(1, 0, At, B0); PG8_MMA(1, 1, At, B1); PG8_BAR; PG8_SCHED;
            } else {
            PG8_LDB(B0, 0, 0); PG8_SCHED; PG8_LDA(At, 0, 0); PG8_STAGE(PG8_SA(1, 1), a1 + hstep, voffA);
            PG8_WAIT_L(8); PG8_BAR; PG8_WAIT_L(0); PG8_MMA(0, 0, At, B0); PG8_BAR; PG8_SCHED;
            PG8_LDB(B1, 0, 1); PG8_STAGE(PG8_SB(0, 0), b2, voffB);
            PG8_BAR; PG8_WAIT_L(0); PG8_MMA(0, 1, At, B1); PG8_BAR;
            PG8_LDA(At, 0, 1); PG8_STAGE(PG8_SA(0, 0), a2, voffA);
            PG8_BAR; PG8_WAIT_L(0); PG8_MMA(1, 0, At, B0); PG8_BAR; PG8_SCHED;
            PG8_STAGE(PG8_SB(0, 1), b2 + hstep, voffB);
            PG8_WAIT_V(6); PG8_BAR; PG8_MMA(1, 1, At, B1); PG8_BAR;
            PG8_LDB(B0, 1, 0); PG8_SCHED; PG8_LDA(At, 1, 0); PG8_STAGE(PG8_SA(0, 1), a2 + hstep, voffA);
            PG8_WAIT_L(8); PG8_BAR; PG8_WAIT_L(0); PG8_MMA(0, 0, At, B0); PG8_BAR; PG8_SCHED;
            PG8_LDB(B1, 1, 1); PG8_STAGE(PG8_SB(1, 0), b3, voffB);
            PG8_BAR; PG8_WAIT_L(0); PG8_MMA(0, 1, At, B1); PG8_BAR;
            PG8_LDA(At, 1, 1); PG8_STAGE(PG8_SA(1, 0), a3, voffA);
            PG8_BAR; PG8_WAIT_L(0); PG8_MMA(1, 0, At, B0); PG8_BAR; PG8_SCHED;
            PG8_STAGE(PG8_SB(1, 1), b3 + hstep, voffB);
            PG8_WAIT_V(6); PG8_BAR; PG8_MMA(1, 1, At, B1); PG8_BAR;
            }
        }
        if constexpr (ALIGN_EPI) { if (wr == 0) PG8_BAR; }
        if constexpr (!Epi::AFTER_DRAIN) { E(acc, cur, wr, wc, fr, fq); S.done(cur); }
        if (!has_next) break;
#pragma unroll
        for (int a = 0; a < 2; ++a)
#pragma unroll
            for (int b = 0; b < 2; ++b)
#pragma unroll
                for (int m = 0; m < 4; ++m)
#pragma unroll
                    for (int n = 0; n < 2; ++n) acc[a][b][m][n] = (f32x4){0.f, 0.f, 0.f, 0.f};
        cur = nxt; cA = nA; cB = nB; ++ui;
        if constexpr (ALIGN_EPI) { if (wr == 1) PG8_BAR; }
    }
    PG8_WAIT_V(0);
    if constexpr (!ALIGN_EPI) { if (wr == 0) PG8_BAR; }
    PG8_BAR;
    if constexpr (Epi::AFTER_DRAIN) { E.fused(acc, cur, wr, wc, fr, fq, lds, wid, lane); S.done(cur); }
#undef PG8_SA
#undef PG8_SB
#undef PG8_STAGE
#undef PG8_LDA
#undef PG8_LDB
#undef PG8_MMA
#undef PG8_WAIT_V
#undef PG8_WAIT_L
#undef PG8_BAR
#undef PG8_SCHED
}
}

struct EpiGU8 {
  static constexpr bool PERM = true, AFTER_DRAIN = false;
  const float* ssq; bf16_t* hbuf;
  __device__ __forceinline__ void operator()(const pg8::f32x4 (&acc)[2][2][4][2], const pg8::Unit& u, int wr, int wc, int fr, int fq) const {
    int z; asm volatile("v_mov_b32 %0, 0" : "=v"(z));
    const int row0 = u.pm * 256 + wr * 64 + fr + z, col0 = u.pn * 128 + wc * 32 + 8 * fq + z;
#pragma unroll
    for (int ai = 0; ai < 2; ++ai) {
      float rs[4];
#pragma unroll
      for (int m = 0; m < 4; ++m) { const f32x4 a = *(const f32x4*)(ssq + (unsigned)(row0 + ai * 128 + m * 16) * 16 + 4 * fq); rs[m] = (a[0] + a[1]) + (a[2] + a[3]); }
#pragma unroll
      for (int m = 0; m < 4; ++m) { float v = rs[m]; v += __shfl_xor(v, 16); v += __shfl_xor(v, 32); rs[m] = rsqrtf(v * (1.f / 1024.f) + EPS); }
#pragma unroll
      for (int m = 0; m < 4; ++m) {
        const float r = rs[m]; float v[8];
#pragma unroll
        for (int n = 0; n < 2; ++n)
#pragma unroll
          for (int c = 0; c < 4; ++c) { const float g = acc[ai][0][m][n][c] * r, uu = acc[ai][1][m][n][c] * r; v[4 * n + c] = g * sigm(g) * uu; }
        u32x4 w; w.x = pk2(v[0], v[1]); w.y = pk2(v[2], v[3]); w.z = pk2(v[4], v[5]); w.w = pk2(v[6], v[7]);
        *(u32x4*)(hbuf + (unsigned)(row0 + ai * 128 + m * 16) * DFF + col0) = w;
      }
      asm volatile("" ::: "memory");
    }
  }
};
struct EpiRes8 {
  static constexpr bool PERM = true, AFTER_DRAIN = false;
  typedef _Float16 h8_t __attribute__((ext_vector_type(8))); typedef float f8_t __attribute__((ext_vector_type(8)));
  _Float16* x16; float* xout; bf16_t* xb; float* ssq; float sc; int aux;
  __device__ __forceinline__ void operator()(const pg8::f32x4 (&acc)[2][2][4][2], const pg8::Unit& u, int wr, int wc, int fr, int fq) const {
    int z; asm volatile("v_mov_b32 %0, 0" : "=v"(z));
    const int row0 = u.pm * 256 + wr * 64 + fr + z, colb = u.pn * 256 + wc * 32 + 8 * fq + z;
#pragma unroll
    for (int ai = 0; ai < 2; ++ai)
#pragma unroll
      for (int m = 0; m < 4; ++m) {
        const int tok = row0 + ai * 128 + m * 16; float ss = 0.f;
#pragma unroll
        for (int bj = 0; bj < 2; ++bj) {
          const unsigned off = (unsigned)tok * DM + colb + 128 * bj;
          f8_t n = __builtin_convertvector(*(const h8_t*)(x16 + off), f8_t);
#pragma unroll
          for (int c = 0; c < 4; ++c) { n[c] += sc * acc[ai][bj][m][0][c]; n[4 + c] += sc * acc[ai][bj][m][1][c]; }
          if (aux) {
            *(h8_t*)(x16 + off) = __builtin_convertvector(n, h8_t);
            ss += ((n[0] * n[0] + n[1] * n[1]) + (n[2] * n[2] + n[3] * n[3])) + ((n[4] * n[4] + n[5] * n[5]) + (n[6] * n[6] + n[7] * n[7]));
          } else {
            *(f32x4*)(xout + off) = (f32x4){n[0], n[1], n[2], n[3]}; *(f32x4*)(xout + off + 4) = (f32x4){n[4], n[5], n[6], n[7]};
          }
        }
        if (aux) { ss += __shfl_xor(ss, 16); ss += __shfl_xor(ss, 32); if (fq == 0) ssq[(unsigned)tok * 16 + u.pn * 4 + wc] = ss; }
        if (m & 1) asm volatile("" ::: "memory");
      }
  }
};

template <bool FULL, int MODE, class Epi>
__device__ __forceinline__ void gemm_phase(const bf16_t* __restrict__ P, int ldp, int NP, const bf16_t* __restrict__ Q, int ldq, int K, char* smem, const Epi& epi) {
  constexpr int PITCH = 144, OPB = 256 * PITCH;
  const int G = gridDim.x, bid = blockIdx.x;
  const int PP = (NP % 4 == 0) ? 4 : ((NP % 2 == 0) ? 2 : 1);
  const int L = G >> 3;
  const bool patch = (G & 7) == 0 && (L % PP) == 0 && (64 % (L / PP)) == 0;
  const int xcd = bid & 7, loc = bid >> 3, PQ = patch ? L / PP : 1, npp = NP / PP, npatch = patch ? npp * (64 / PQ) : 0;
  const int niter = (MODE == 1) ? (256 + G - 1) / G : (patch ? (npatch + 7) / 8 : (NP * 64 + G - 1) / G);
  auto coords = [&](int it, int& p0, int& q0) -> bool {
    if (MODE == 1) { const int t = bid + it * G; p0 = (t >> 5) * 128; q0 = t * 256; return t < 256; }
    if (patch) { const int pidx = xcd + 8 * it; p0 = ((pidx % npp) * PP + loc % PP) * 256; q0 = ((pidx / npp) * PQ + loc / PP) * 256; return pidx < npatch; }
    const int t = bid + it * G; p0 = (t % NP) * 256; q0 = (t / NP) * 256; return t < NP * 64;
  };
  int tid = threadIdx.x; asm volatile("" : "+v"(tid));
  const int lane = tid & 63, wid = tid >> 6;
  const int wp = wid >> 2, wq = wid & 3;
  const int r = lane & 31, h = lane >> 5;
  const int lr = tid >> 3, lc = tid & 7;
  const int nk = K >> 6;
  const int rot = (int)((unsigned)loc % (unsigned)nk);
  char* sP = smem; char* sQ = smem + 2 * OPB;
  const int wofs = lr * PITCH + lc * 16;
  const int aofs = (wp * 128 + r) * PITCH + h * 16;
  const int bofs = (wq * 64 + r) * PITCH + h * 16;
  int it = 0, p0 = 0, q0 = 0;
  if (niter <= 0 || !coords(0, p0, q0)) return;
  const bf16_t* gp = P + (size_t)(p0 + lr) * ldp + lc * 8;
  const bf16_t* gq = Q + (size_t)(q0 + lr) * ldq + lc * 8;
  u32x4 rp[4], rq[4];
#pragma unroll
  for (int j = 0; j < 4; ++j) { rp[j] = *(const u32x4*)(gp + (size_t)(64 * j) * ldp + rot * 64); rq[j] = *(const u32x4*)(gq + (size_t)(64 * j) * ldq + rot * 64); }
#pragma unroll 1
  for (;;) {
    float pre[2];
    epi.prefetch(pre, q0 + wq * 64, lane);
    f32x16 acc[4][2];
#pragma unroll
    for (int a = 0; a < 4; ++a)
#pragma unroll
      for (int b = 0; b < 2; ++b)
#pragma unroll
        for (int i = 0; i < 16; ++i) acc[a][b][i] = 0.f;
    __syncthreads();
#pragma unroll
    for (int j = 0; j < 4; ++j) { *(u32x4*)(sP + wofs + j * 64 * PITCH) = rp[j]; *(u32x4*)(sQ + wofs + j * 64 * PITCH) = rq[j]; }
    {
      int kk = 1 + rot; if (kk >= nk) kk -= nk;
      const int ko = kk * 64;
#pragma unroll
      for (int j = 0; j < 4; ++j) { rp[j] = *(const u32x4*)(gp + (size_t)(64 * j) * ldp + ko); rq[j] = *(const u32x4*)(gq + (size_t)(64 * j) * ldq + ko); }
    }
#pragma unroll 1
    for (int kt = 0; kt < nk; ++kt) {
      const int cur = kt & 1;
      __syncthreads();
      if (kt + 1 < nk) {
        char* dP = sP + (cur ^ 1) * OPB + wofs; char* dQ = sQ + (cur ^ 1) * OPB + wofs;
#pragma unroll
        for (int j = 0; j < 4; ++j) { *(u32x4*)(dP + j * 64 * PITCH) = rp[j]; *(u32x4*)(dQ + j * 64 * PITCH) = rq[j]; }
        if (kt + 2 < nk) {
          int kk = kt + 2 + rot; if (kk >= nk) kk -= nk;
          const int ko = kk * 64;
#pragma unroll
          for (int j = 0; j < 4; ++j) { rp[j] = *(const u32x4*)(gp + (size_t)(64 * j) * ldp + ko); rq[j] = *(const u32x4*)(gq + (size_t)(64 * j) * ldq + ko); }
        }
      }
      const char* ab = sP + cur * OPB + aofs; const char* bb = sQ + cur * OPB + bofs;
#pragma unroll
      for (int ks = 0; ks < 4; ++ks) {
        bf16x8 a[4], b[2];
#pragma unroll
        for (int pi = 0; pi < 4; ++pi) a[pi] = *(const bf16x8*)(ab + pi * 32 * PITCH + ks * 32);
#pragma unroll
        for (int qi = 0; qi < 2; ++qi) b[qi] = *(const bf16x8*)(bb + qi * 32 * PITCH + ks * 32);
#pragma unroll
        for (int pi = 0; pi < 4; ++pi)
#pragma unroll
          for (int qi = 0; qi < 2; ++qi) acc[pi][qi] = MFMA(a[pi], b[qi], acc[pi][qi]);
      }
    }
    int np0 = 0, nq0 = 0;
    const bool has_next = (it + 1 < niter) && coords(it + 1, np0, nq0);
    if (Epi::XPF && has_next) {
      gp = P + (size_t)(np0 + lr) * ldp + lc * 8; gq = Q + (size_t)(nq0 + lr) * ldq + lc * 8;
#pragma unroll
      for (int j = 0; j < 4; ++j) { rp[j] = *(const u32x4*)(gp + (size_t)(64 * j) * ldp + rot * 64); rq[j] = *(const u32x4*)(gq + (size_t)(64 * j) * ldq + rot * 64); }
    }
    if constexpr (Epi::LDS_OUT) {
      __syncthreads();
      epi.to_lds(*(f32x16 (*)[2][2])(&acc[0]), smem, wp * 64, wq * 64, lane, pre);
      epi.to_lds(*(f32x16 (*)[2][2])(&acc[2]), smem, wp * 64 + 32, wq * 64, lane, pre);
      __syncthreads();
      {
        bf16_t* ob = epi.out_base() + (size_t)q0 * Epi::OUT_LD + (p0 >> 1);
        const int orow = tid >> 4, och = tid & 15;
#pragma unroll
        for (int ps = 0; ps < 8; ++ps) {
          const int row = ps * 32 + orow;
          const u32x4 v = *(const u32x4*)(smem + row * 264 + och * 16);
          *(u32x4*)(ob + (size_t)row * Epi::OUT_LD + och * 8) = v;
        }
      }
    } else if constexpr (FULL) {
      epi(acc, p0 + wp * 128, q0 + wq * 64, lane, pre);
    } else {
      epi(*(f32x16 (*)[2][2])(&acc[0]), p0 + wp * 128, q0 + wq * 64, lane, pre);
      epi(*(f32x16 (*)[2][2])(&acc[2]), p0 + wp * 128 + 64, q0 + wq * 64, lane, pre);
    }
    if (!has_next) break;
    ++it; p0 = np0; q0 = nq0;
    if (!Epi::XPF) {
      gp = P + (size_t)(p0 + lr) * ldp + lc * 8; gq = Q + (size_t)(q0 + lr) * ldq + lc * 8;
#pragma unroll
      for (int j = 0; j < 4; ++j) { rp[j] = *(const u32x4*)(gp + (size_t)(64 * j) * ldp + rot * 64); rq[j] = *(const u32x4*)(gq + (size_t)(64 * j) * ldq + rot * 64); }
    }
  }
}


__device__ __forceinline__ void wave_atomic_max_pos(float v, unsigned* dst) {
#pragma unroll
  for (int o = 32; o >= 1; o >>= 1) v = fmaxf(v, __shfl_xor(v, o));
  if ((threadIdx.x & 63) == 0) atomicMax(dst + (blockIdx.x & 7) * 64, __float_as_uint(v));
}
__device__ __forceinline__ float kmax_of(const unsigned* kmx, int idx) { unsigned m = 0u;
#pragma unroll
  for (int sl = 0; sl < 8; ++sl) m = max(m, kmx[sl * 64 + idx]);
  return sqrtf(__uint_as_float(m)); }
constexpr size_t O_KMAX = 14336;

struct EpiGU {
  static constexpr bool LDS_OUT = true;
  static constexpr bool XPF = true;
  const float* ssq; bf16_t* hbuf;
  static constexpr int OUT_LD = DFF;
  __device__ __forceinline__ bf16_t* out_base() const { return hbuf; }
  __device__ __forceinline__ void to_lds(f32x16 (&acc)[2][2], char* smem, int hl0, int tl0, int lane, const float (&pre)[2]) const {
    const int r = lane & 31, h = lane >> 5;
#pragma unroll
    for (int qi = 0; qi < 2; ++qi) {
      const float rs = pre[qi];
      char* dst = smem + (tl0 + 32 * qi + r) * 264 + (hl0 + 4 * h) * 2;
#pragma unroll
      for (int i4 = 0; i4 < 4; ++i4) {
        float v[4];
#pragma unroll
        for (int c = 0; c < 4; ++c) { const float g = acc[0][qi][4 * i4 + c] * rs, u = acc[1][qi][4 * i4 + c] * rs; v[c] = g * sigm(g) * u; }
        u32x2 w; w.x = pk2(v[0], v[1]); w.y = pk2(v[2], v[3]);
        *(u32x2*)(dst + 16 * i4) = w;
      }
    }
  }
  __device__ __forceinline__ void prefetch(float (&pre)[2], int tbase, int lane) const { const int r = lane & 31;
#pragma unroll
    for (int qi = 0; qi < 2; ++qi) pre[qi] = rstd16(ssq, tbase + 32 * qi + r); }
  __device__ __forceinline__ void operator()(f32x16 (&acc)[2][2], int fbase, int tbase, int lane, const float (&pre)[2]) const {
    const int r = lane & 31, h = lane >> 5, j0 = fbase >> 1;
#pragma unroll
    for (int qi = 0; qi < 2; ++qi) {
      const int tok = tbase + 32 * qi + r; const float rs = pre[qi];
      bf16_t* hp = hbuf + (unsigned)tok * DFF + j0 + 4 * h;
#pragma unroll
      for (int i4 = 0; i4 < 4; ++i4) {
        float v[4];
#pragma unroll
        for (int c = 0; c < 4; ++c) { const float g = acc[0][qi][4 * i4 + c] * rs, u = acc[1][qi][4 * i4 + c] * rs; v[c] = g * sigm(g) * u; }
        u32x2 w; w.x = pk2(v[0], v[1]); w.y = pk2(v[2], v[3]);
        *(u32x2*)(hp + 8 * i4) = w;
      }
    }
  }
};

struct EpiResid {
  static constexpr bool LDS_OUT = false;
  static constexpr bool XPF = true;
  const float* xold; float* xnew; bf16_t* xb; float* ssq; float sc; int aux;
  __device__ __forceinline__ void prefetch(float (&pre)[2], int tbase, int lane) const { pre[0] = 0.f; pre[1] = 0.f; }
  __device__ __forceinline__ void operator()(f32x16 (&acc)[2][2], int fbase, int tbase, int lane, const float (&pre)[2]) const {
    const int r = lane & 31, h = lane >> 5;
#pragma unroll
    for (int qi = 0; qi < 2; ++qi) {
      const int tok = tbase + 32 * qi + r; float ss = 0.f;
#pragma unroll
      for (int pi = 0; pi < 2; ++pi)
#pragma unroll
        for (int i4 = 0; i4 < 4; ++i4) {
          const size_t off = (unsigned)tok * DM + fbase + 32 * pi + 8 * i4 + 4 * h;
          const f32x4 xo = *(const f32x4*)(xold + off); f32x4 xn;
#pragma unroll
          for (int c = 0; c < 4; ++c) xn[c] = xo[c] + sc * acc[pi][qi][4 * i4 + c];
          *(f32x4*)(xnew + off) = xn;
          if (aux) { u32x2 w; w.x = pk2(xn[0], xn[1]); w.y = pk2(xn[2], xn[3]); *(u32x2*)(xb + off) = w; ss += (xn[0] * xn[0] + xn[1] * xn[1]) + (xn[2] * xn[2] + xn[3] * xn[3]); }
        }
      if (aux) { ss += __shfl_xor(ss, 32); if (h == 0) ssq[(unsigned)tok * 16 + (fbase >> 6)] = ss; }
    }
  }
};

__device__ __forceinline__ float ss64(const float (&v)[2][16]) {
  float s = 0.f;
#pragma unroll
  for (int pi = 0; pi < 2; ++pi)
#pragma unroll
    for (int i = 0; i < 16; ++i) s += v[pi][i] * v[pi][i];
  return s + __shfl_xor(s, 32);
}
__device__ __forceinline__ void store_tok64_bf16(bf16_t* dst  , const float (&v)[2][16], int h) {
#pragma unroll
  for (int pi = 0; pi < 2; ++pi)
#pragma unroll
    for (int i4 = 0; i4 < 4; ++i4) { u32x2 w; w.x = pk2(v[pi][4 * i4], v[pi][4 * i4 + 1]); w.y = pk2(v[pi][4 * i4 + 2], v[pi][4 * i4 + 3]); *(u32x2*)(dst + 32 * pi + 8 * i4 + 4 * h) = w; }
}
__device__ __forceinline__ void store_feat_major(bf16_t* dst, unsigned pitch, const float (&v)[2][16], int h) {
#pragma unroll
  for (int pi = 0; pi < 2; ++pi)
#pragma unroll
    for (int i = 0; i < 16; ++i) dst[(unsigned)(32 * pi + 8 * (i >> 2) + 4 * h + (i & 3)) * pitch] = f2bf(v[pi][i]);
}

struct EpiEvIn {
  static constexpr bool LDS_OUT = false;
  static constexpr bool XPF = true;
  const float* ssq; const float* sgu_norm; const float* q_norm; const float* k_norm; const float* cos64; const float* sin64;
  bf16_t* ub; bf16_t* vt; bf16_t* qb; bf16_t* kb; bf16_t* vtb; unsigned* kmax2;
  __device__ __forceinline__ void prefetch(float (&pre)[2], int tbase, int lane) const { const int r = lane & 31;
#pragma unroll
    for (int qi = 0; qi < 2; ++qi) pre[qi] = rstd16(ssq, tbase + 32 * qi + r); }
  __device__ __forceinline__ void operator()(f32x16 (&acc)[2][2], int fbase, int tbase, int lane, const float (&pre)[2]) const {
    const int r = lane & 31, h = lane >> 5, gidx = fbase >> 6;
#pragma unroll
    for (int qi = 0; qi < 2; ++qi) {
      const int tok = tbase + 32 * qi + r; const float rs = pre[qi];
      const int bb = tok >> 13, pos = tok & (S - 1);
      float v[2][16];
#pragma unroll
      for (int pi = 0; pi < 2; ++pi)
#pragma unroll
        for (int i = 0; i < 16; ++i) v[pi][i] = acc[pi][qi][i] * rs;
      if (gidx < 8) {
#pragma unroll
        for (int pi = 0; pi < 2; ++pi)
#pragma unroll
          for (int i = 0; i < 16; ++i) v[pi][i] = gelu_tanh(v[pi][i]);
        store_tok64_bf16(ub + (unsigned)tok * 512 + gidx * 64, v, h);
      } else if (gidx < 16) {
        const int g = gidx - 8;
#pragma unroll
        for (int pi = 0; pi < 2; ++pi)
#pragma unroll
          for (int i = 0; i < 16; ++i) v[pi][i] = gelu_tanh(v[pi][i]);
        const float rn = rsqrtf(ss64(v) * (1.f / 64.f) + EPS);
#pragma unroll
        for (int pi = 0; pi < 2; ++pi)
#pragma unroll
          for (int i = 0; i < 16; ++i) v[pi][i] *= rn * sgu_norm[g * 64 + 32 * pi + 8 * (i >> 2) + 4 * h + (i & 3)];
        store_feat_major(vt + ((unsigned)(g * 128 + (tok >> 7)) * 64) * 128 + (tok & 127), 128, v, h);
      } else if (gidx < 32) {
        const bool isq = gidx < 24; const int hm = isq ? gidx - 16 : gidx - 24;
        const float* gn = isq ? q_norm : k_norm;
        const float rn = rsqrtf(ss64(v) * (1.f / 64.f) + EPS) * (isq ? 0.125f * LOG2E : 1.f);
#pragma unroll
        for (int i = 0; i < 16; ++i) {
          const int d = 8 * (i >> 2) + 4 * h + (i & 3);
          const float x1 = v[0][i] * rn * gn[d], x2 = v[1][i] * rn * gn[d + 32];
          const float c = cos64[pos * 32 + d], s = sin64[pos * 32 + d];
          v[0][i] = x1 * c - x2 * s; v[1][i] = x1 * s + x2 * c;
        }
        store_tok64_bf16((isq ? qb : kb) + ((unsigned)(bb * 8 + hm) * S + pos) * 64, v, h);
        if (!isq) wave_atomic_max_pos(ss64(v), kmax2 + bb * 8 + hm);
      } else {
        const int hv = (gidx - 32) >> 1, eh = (gidx - 32) & 1;
        store_feat_major(vtb + ((unsigned)(bb * 4 + hv) * 128 + 64 * eh) * S + pos, S, v, h);
      }
    }
  }
};

__device__ __forceinline__ void rope32(float (&v)[16], const float* __restrict__ cos32, const float* __restrict__ sin32, int p, int h) {
#pragma unroll
  for (int i = 0; i < 8; ++i) {
    const int d = 8 * (i >> 2) + 4 * h + (i & 3);
    const float c = cos32[p * 16 + d], s = sin32[p * 16 + d];
    const float x1 = v[i], x2 = v[i + 8];
    v[i] = x1 * c - x2 * s; v[i + 8] = x1 * s + x2 * c;
  }
}

struct EpiOdIn {
  static constexpr bool LDS_OUT = false;
  static constexpr bool XPF = true;
  const float* ssq; const float* gq_norm; const float* gk_norm; const float* cos32; const float* sin32;
  bf16_t* cq; bf16_t* ckv; float* ssq2; float* kpe; bf16_t* qd; bf16_t* kd; bf16_t* vtd; unsigned* kmax2;
  __device__ __forceinline__ void prefetch(float (&pre)[2], int tbase, int lane) const { const int r = lane & 31;
#pragma unroll
    for (int qi = 0; qi < 2; ++qi) pre[qi] = rstd16(ssq, tbase + 32 * qi + r); }
  __device__ __forceinline__ void operator()(f32x16 (&acc)[2][2], int fbase, int tbase, int lane, const float (&pre)[2]) const {
    const int r = lane & 31, h = lane >> 5, gidx = fbase >> 6;
    if (gidx >= 19) return;
#pragma unroll
    for (int qi = 0; qi < 2; ++qi) {
      const int tok = tbase + 32 * qi + r; const float rs = pre[qi];
      const int bb = tok >> 13, pos = tok & (S - 1);
      float v[2][16];
#pragma unroll
      for (int pi = 0; pi < 2; ++pi)
#pragma unroll
        for (int i = 0; i < 16; ++i) v[pi][i] = acc[pi][qi][i] * rs;
      if (gidx < 6) {
        const float ss = ss64(v);
        if (h == 0) ssq2[(unsigned)tok * 8 + gidx] = ss;
        if (gidx < 4) store_tok64_bf16(cq + (unsigned)tok * 256 + gidx * 64, v, h);
        else store_tok64_bf16(ckv + (unsigned)tok * 128 + (gidx - 4) * 64, v, h);
      } else if (gidx == 6) {
#pragma unroll
        for (int i4 = 0; i4 < 4; ++i4) { f32x4 w = {v[0][4 * i4], v[0][4 * i4 + 1], v[0][4 * i4 + 2], v[0][4 * i4 + 3]}; *(f32x4*)(kpe + (unsigned)tok * 32 + 8 * i4 + 4 * h) = w; }
      } else if (gidx < 17) {
        const bool isq = gidx < 15; const float* gn = isq ? gq_norm : gk_norm;
        const float rn = rsqrtf(ss64(v) * (1.f / 64.f) + EPS) * (isq ? 0.125f * LOG2E : 1.f);
#pragma unroll
        for (int pi = 0; pi < 2; ++pi)
#pragma unroll
          for (int i = 0; i < 16; ++i) v[pi][i] *= rn * gn[32 * pi + 8 * (i >> 2) + 4 * h + (i & 3)];
        rope32(v[0], cos32, sin32, pos >> 6, h);
        rope32(v[1], cos32, sin32, pos & 63, h);
        if (isq) store_tok64_bf16(qd + ((unsigned)(bb * 8 + (gidx - 7)) * S + pos) * 64, v, h);
        else { store_tok64_bf16(kd + ((unsigned)(bb * 2 + (gidx - 15)) * S + pos) * 64, v, h); wave_atomic_max_pos(ss64(v), kmax2 + 32 + bb * 2 + (gidx - 15)); }
      } else {
        store_feat_major(vtd + ((unsigned)(bb * 2 + (gidx - 17)) * 64) * S + pos, S, v, h);
      }
    }
  }
};

struct EpiUq {
  static constexpr bool LDS_OUT = false;
  static constexpr bool XPF = false;
  const float* ssq2; const float* qn; const float* cos32; const float* sin32; bf16_t* qc;
  __device__ __forceinline__ void prefetch(float (&pre)[2], int tbase, int lane) const { const int r = lane & 31;
#pragma unroll
    for (int qi = 0; qi < 2; ++qi) { const f32x4 sq = *(const f32x4*)(ssq2 + (unsigned)(tbase + 32 * qi + r) * 8); pre[qi] = rsqrtf(((sq[0] + sq[1]) + (sq[2] + sq[3])) * (1.f / 256.f) + EPS); } }
  __device__ __forceinline__ void operator()(f32x16 (&acc)[4][2], int fbase, int tbase, int lane, const float (&pre)[2]) const {
    const int r = lane & 31, h = lane >> 5, head = fbase >> 7;
#pragma unroll
    for (int qi = 0; qi < 2; ++qi) {
    const int tok = tbase + 32 * qi + r, bb = tok >> 13, pos = tok & (S - 1);
    const float rs = pre[qi];
    float v[3][16]; float ss = 0.f;
#pragma unroll
    for (int pi = 0; pi < 3; ++pi)
#pragma unroll
      for (int i = 0; i < 16; ++i) { v[pi][i] = acc[pi][qi][i] * rs; ss += v[pi][i] * v[pi][i]; }
    ss += __shfl_xor(ss, 32);
    const float rn = rsqrtf(ss * (1.f / 96.f) + EPS) * (0.10206207261596575f * LOG2E);
#pragma unroll
    for (int pi = 0; pi < 3; ++pi)
#pragma unroll
      for (int i = 0; i < 16; ++i) v[pi][i] *= rn * qn[32 * pi + 8 * (i >> 2) + 4 * h + (i & 3)];
    rope32(v[2], cos32, sin32, pos, h);
    bf16_t* dst = qc + ((unsigned)(bb * 8 + head) * S + pos) * 96;
#pragma unroll
    for (int pi = 0; pi < 3; ++pi)
#pragma unroll
      for (int i4 = 0; i4 < 4; ++i4) { u32x2 w; w.x = pk2(v[pi][4 * i4], v[pi][4 * i4 + 1]); w.y = pk2(v[pi][4 * i4 + 2], v[pi][4 * i4 + 3]); *(u32x2*)(dst + 32 * pi + 8 * i4 + 4 * h) = w; }
    }
  }
};

struct EpiUkv {
  static constexpr bool LDS_OUT = false;
  static constexpr bool XPF = false;
  const float* ssq2; const float* kn; const float* kpe; const float* cos32; const float* sin32; bf16_t* kc; bf16_t* vtc; unsigned* kmax2;
  __device__ __forceinline__ void prefetch(float (&pre)[2], int tbase, int lane) const { const int r = lane & 31;
#pragma unroll
    for (int qi = 0; qi < 2; ++qi) { const unsigned t8 = (unsigned)(tbase + 32 * qi + r) * 8; pre[qi] = rsqrtf((ssq2[t8 + 4] + ssq2[t8 + 5]) * (1.f / 128.f) + EPS); } }
  __device__ __forceinline__ void operator()(f32x16 (&acc)[2][2], int fbase, int tbase, int lane, const float (&pre)[2]) const {
    int z; asm volatile("v_mov_b32 %0, 0" : "=v"(z));
    const int r = (lane & 31) + z, h = lane >> 5, head = fbase >> 7, isv = (fbase >> 6) & 1;
    float kmx_run = 0.f;
#pragma unroll
    for (int qi = 0; qi < 2; ++qi) {
      const int tok = tbase + 32 * qi + r, bb = tok >> 13, pos = tok & (S - 1);
      const float rs = pre[qi];
      float v[2][16];
#pragma unroll
      for (int pi = 0; pi < 2; ++pi)
#pragma unroll
        for (int i = 0; i < 16; ++i) v[pi][i] = acc[pi][qi][i] * rs;
      if (isv) {
        store_feat_major(vtc + ((unsigned)(bb * 8 + head) * 64) * S + pos, S, v, h);
      } else {
        float pe[16]; float ss = 0.f;
#pragma unroll
        for (int i4 = 0; i4 < 4; ++i4) { const f32x4 w = *(const f32x4*)(kpe + (unsigned)tok * 32 + 8 * i4 + 4 * h);
#pragma unroll
          for (int c = 0; c < 4; ++c) { pe[4 * i4 + c] = w[c]; ss += w[c] * w[c]; } }
#pragma unroll
        for (int pi = 0; pi < 2; ++pi)
#pragma unroll
          for (int i = 0; i < 16; ++i) ss += v[pi][i] * v[pi][i];
        ss += __shfl_xor(ss, 32);
        const float rn = rsqrtf(ss * (1.f / 96.f) + EPS);
#pragma unroll
        for (int pi = 0; pi < 2; ++pi)
#pragma unroll
          for (int i = 0; i < 16; ++i) v[pi][i] *= rn * kn[32 * pi + 8 * (i >> 2) + 4 * h + (i & 3)];
#pragma unroll
        for (int i = 0; i < 16; ++i) pe[i] *= rn * kn[64 + 8 * (i >> 2) + 4 * h + (i & 3)];
        rope32(pe, cos32, sin32, pos, h);
        { float kk = 0.f;
#pragma unroll
          for (int i = 0; i < 16; ++i) kk += pe[i] * pe[i];
          kmx_run = fmaxf(kmx_run, ss64(v) + kk + __shfl_xor(kk, 32)); }
        bf16_t* dst = kc + ((unsigned)(bb * 8 + head) * S + pos) * 96;
        store_tok64_bf16(dst, v, h);
#pragma unroll
        for (int i4 = 0; i4 < 4; ++i4) { u32x2 w; w.x = pk2(pe[4 * i4], pe[4 * i4 + 1]); w.y = pk2(pe[4 * i4 + 2], pe[4 * i4 + 3]); *(u32x2*)(dst + 64 + 8 * i4 + 4 * h) = w; }
      }
    }
    if (!isv) wave_atomic_max_pos(kmx_run, kmax2 + 16 + (tbase >> 13) * 8 + head);
  }
};

struct EpiGmlp {
  static constexpr bool LDS_OUT = false;
  static constexpr bool XPF = false;
  const float* b_s; const bf16_t* ub; bf16_t* mix;
  __device__ __forceinline__ void prefetch(float (&pre)[2], int tbase, int lane) const { pre[0] = 0.f; pre[1] = 0.f; }
  __device__ __forceinline__ void operator()(f32x16 (&acc)[2][2], int fbase, int tbase, int lane, const float (&pre)[2]) const {
    const int r = lane & 31, h = lane >> 5;
    const int g = tbase >> 13, chunk = (tbase & 8191) >> 6;
    fbase -= g * 128;
    if (fbase >= 128) return;
    const float* bs = b_s + g * 128 + fbase + 4 * h;
#pragma unroll
    for (int qi = 0; qi < 2; ++qi) {
      const unsigned tok0 = (unsigned)(chunk * 128 + fbase + 4 * h);
      const unsigned uo = tok0 * 512u + (unsigned)(g * 64 + 32 * qi + r), mo = tok0 * 1024u + (unsigned)(g * 64 + 32 * qi + r);
#pragma unroll
      for (int pi = 0; pi < 2; ++pi)
#pragma unroll
        for (int i = 0; i < 16; ++i) {
          const int io = 32 * pi + 8 * (i >> 2) + (i & 3);
          const float uu = bf2f(ub[uo + (unsigned)(io * 512)]);
          mix[mo + (unsigned)(io * 1024)] = f2bf(uu * (acc[pi][qi][i] + bs[io]));
        }
    }
  }
};


__device__ __forceinline__ float grp_sum(float v) { v += __shfl_xor(v, 16); v += __shfl_xor(v, 32); return v; }
__device__ __forceinline__ float lane32_partner(float a, int lane) {
  auto rr = __builtin_amdgcn_permlane32_swap(__float_as_uint(a), __float_as_uint(a), false, false);
  return __uint_as_float(lane < 32 ? rr[1] : rr[0]);
}
__device__ __forceinline__ void st8_bf16(bf16_t* dst, const float (&v)[8]) { u32x4 w; w.x = pk2(v[0], v[1]); w.y = pk2(v[2], v[3]); w.z = pk2(v[4], v[5]); w.w = pk2(v[6], v[7]); *(u32x4*)dst = w; }

struct EpiEvIn8 {
  static constexpr bool PERM = true, AFTER_DRAIN = false;
  const float* ssq; const float* sgu_norm; const float* q_norm; const float* k_norm; const float* cos64; const float* sin64;
  bf16_t* ub; bf16_t* vt; bf16_t* qb; bf16_t* kb; bf16_t* vtb; unsigned* kmax2;
  __device__ __forceinline__ void operator()(const pg8::f32x4 (&acc)[2][2][4][2], const pg8::Unit& u, int wr, int wc, int fr, int fq) const {
    int z; asm volatile("v_mov_b32 %0, 0" : "=v"(z));
    const int gi = 4 * u.pn + wc;
    const int row0 = u.pm * 256 + wr * 64 + fr + z;
    float kmx_run = 0.f;
#pragma unroll
    for (int ai = 0; ai < 2; ++ai) {
      float rs[4];
#pragma unroll
      for (int m = 0; m < 4; ++m) { const f32x4 a = *(const f32x4*)(ssq + (unsigned)(row0 + ai * 128 + m * 16) * 16 + 4 * fq); rs[m] = (a[0] + a[1]) + (a[2] + a[3]); }
#pragma unroll
      for (int m = 0; m < 4; ++m) rs[m] = rsqrtf(grp_sum(rs[m]) * (1.f / 1024.f) + EPS);
#pragma unroll
      for (int m = 0; m < 4; ++m) {
        const int tok = row0 + ai * 128 + m * 16, bb = tok >> 13, pos = tok & (S - 1);
        float v[2][8];
#pragma unroll
        for (int bj = 0; bj < 2; ++bj)
#pragma unroll
          for (int n = 0; n < 2; ++n)
#pragma unroll
            for (int c = 0; c < 4; ++c) v[bj][4 * n + c] = acc[ai][bj][m][n][c] * rs[m];
        if (gi < 8) {
#pragma unroll
          for (int bj = 0; bj < 2; ++bj) {
#pragma unroll
            for (int e = 0; e < 8; ++e) v[bj][e] = gelu_tanh(v[bj][e]);
            st8_bf16(ub + (unsigned)tok * 512 + gi * 64 + 32 * bj + 8 * fq, v[bj]);
          }
        } else if (gi < 16) {
          const int g = gi - 8; float ss = 0.f;
#pragma unroll
          for (int bj = 0; bj < 2; ++bj)
#pragma unroll
            for (int e = 0; e < 8; ++e) { v[bj][e] = gelu_tanh(v[bj][e]); ss += v[bj][e] * v[bj][e]; }
          const float rn = rsqrtf(grp_sum(ss) * (1.f / 64.f) + EPS);
          bf16_t* dst = vt + ((unsigned)(g * 128 + (tok >> 7)) * 64 + 8 * fq) * 128 + (tok & 127);
#pragma unroll
          for (int bj = 0; bj < 2; ++bj)
#pragma unroll
            for (int e = 0; e < 8; ++e) dst[(32 * bj + e) * 128] = f2bf(v[bj][e] * rn * sgu_norm[g * 64 + 32 * bj + 8 * fq + e]);
        } else if (gi < 32) {
          const bool isq = gi < 24; const int hm = isq ? gi - 16 : gi - 24;
          const float* gn = isq ? q_norm : k_norm;
          float ss = 0.f;
#pragma unroll
          for (int bj = 0; bj < 2; ++bj)
#pragma unroll
            for (int e = 0; e < 8; ++e) ss += v[bj][e] * v[bj][e];
          const float rn = rsqrtf(grp_sum(ss) * (1.f / 64.f) + EPS) * (isq ? 0.125f * LOG2E : 1.f);
          const f32x4 c0 = *(const f32x4*)(cos64 + (unsigned)pos * 32 + 8 * fq), c1 = *(const f32x4*)(cos64 + (unsigned)pos * 32 + 8 * fq + 4);
          const f32x4 s0 = *(const f32x4*)(sin64 + (unsigned)pos * 32 + 8 * fq), s1 = *(const f32x4*)(sin64 + (unsigned)pos * 32 + 8 * fq + 4);
          float kk = 0.f;
#pragma unroll
          for (int e = 0; e < 8; ++e) {
            const float x1 = v[0][e] * rn * gn[8 * fq + e], x2 = v[1][e] * rn * gn[32 + 8 * fq + e];
            const float cc = e < 4 ? c0[e & 3] : c1[e & 3], sn = e < 4 ? s0[e & 3] : s1[e & 3];
            v[0][e] = x1 * cc - x2 * sn; v[1][e] = x1 * sn + x2 * cc;
            kk += v[0][e] * v[0][e] + v[1][e] * v[1][e];
          }
          bf16_t* dst = (isq ? qb : kb) + ((unsigned)(bb * 8 + hm) * S + pos) * 64 + 8 * fq;
          st8_bf16(dst, v[0]); st8_bf16(dst + 32, v[1]);
          if (!isq) kmx_run = fmaxf(kmx_run, grp_sum(kk));
        } else {
          const int hv = (gi - 32) >> 1, eh = (gi - 32) & 1;
          bf16_t* dst = vtb + ((unsigned)(bb * 4 + hv) * 128 + 64 * eh + 8 * fq) * S + pos;
#pragma unroll
          for (int bj = 0; bj < 2; ++bj)
#pragma unroll
            for (int e = 0; e < 8; ++e) dst[(unsigned)(32 * bj + e) * S] = f2bf(v[bj][e]);
        }
        if (m & 1) asm volatile("" ::: "memory");
      }
    }
    if (gi >= 24 && gi < 32) wave_atomic_max_pos(kmx_run, kmax2 + ((u.pm * 256) >> 13) * 8 + (gi - 24));
  }
};

struct EpiOdIn8 {
  static constexpr bool PERM = true, AFTER_DRAIN = false;
  const float* ssq; const float* gq_norm; const float* gk_norm; const float* cos32; const float* sin32;
  bf16_t* cq; bf16_t* ckv; float* ssq2; float* kpe; bf16_t* qd; bf16_t* kd; bf16_t* vtd; unsigned* kmax2;
  __device__ __forceinline__ void operator()(const pg8::f32x4 (&acc)[2][2][4][2], const pg8::Unit& u, int wr, int wc, int fr, int fq0) const {
    int z; asm volatile("v_mov_b32 %0, 0" : "=v"(z));
    const int fq = fq0 + z;
    const int gi = 4 * u.pn + wc;
    if (gi >= 19) return;
    const int lane = fr + 16 * fq;
    const int row0 = u.pm * 256 + wr * 64 + 4 * fr + z;
    float kmx_run = 0.f;
#pragma unroll
    for (int ai = 0; ai < 2; ++ai) {
      float rs[4];
#pragma unroll
      for (int m = 0; m < 4; ++m) { const f32x4 a = *(const f32x4*)(ssq + (unsigned)(row0 + ai * 128 + m) * 16 + 4 * fq); rs[m] = (a[0] + a[1]) + (a[2] + a[3]); }
#pragma unroll
      for (int m = 0; m < 4; ++m) rs[m] = rsqrtf(grp_sum(rs[m]) * (1.f / 1024.f) + EPS);
      if (gi >= 17) {
        const int tok0 = row0 + ai * 128, bb0 = tok0 >> 13, pos0 = tok0 & (S - 1);
        bf16_t* dst = vtd + ((unsigned)(bb0 * 2 + (gi - 17)) * 64 + 8 * fq) * S + pos0;
#pragma unroll
        for (int bj = 0; bj < 2; ++bj)
#pragma unroll
          for (int n = 0; n < 2; ++n)
#pragma unroll
            for (int c = 0; c < 4; ++c) {
              u32x2 w; w.x = pk2(acc[ai][bj][0][n][c] * rs[0], acc[ai][bj][1][n][c] * rs[1]); w.y = pk2(acc[ai][bj][2][n][c] * rs[2], acc[ai][bj][3][n][c] * rs[3]);
              *(u32x2*)(dst + (unsigned)(32 * bj + 4 * n + c) * S) = w;
            }
        asm volatile("" ::: "memory");
        continue;
      }
#pragma unroll
      for (int m = 0; m < 4; ++m) {
        const int tok = row0 + ai * 128 + m, bb = tok >> 13, pos = tok & (S - 1);
        float v[2][8];
#pragma unroll
        for (int bj = 0; bj < 2; ++bj)
#pragma unroll
          for (int n = 0; n < 2; ++n)
#pragma unroll
            for (int c = 0; c < 4; ++c) v[bj][4 * n + c] = acc[ai][bj][m][n][c] * rs[m];
        if (gi < 6) {
          float ss = 0.f;
#pragma unroll
          for (int bj = 0; bj < 2; ++bj)
#pragma unroll
            for (int e = 0; e < 8; ++e) ss += v[bj][e] * v[bj][e];
          ss = grp_sum(ss);
          if (fq == 0) ssq2[(unsigned)tok * 8 + gi] = ss;
          bf16_t* dst = (gi < 4) ? cq + (unsigned)tok * 256 + gi * 64 + 8 * fq : ckv + (unsigned)tok * 128 + (gi - 4) * 64 + 8 * fq;
          st8_bf16(dst, v[0]); st8_bf16(dst + 32, v[1]);
        } else if (gi == 6) {
          float* dst = kpe + (unsigned)tok * 32 + 8 * fq;
          *(f32x4*)dst = (f32x4){v[0][0], v[0][1], v[0][2], v[0][3]}; *(f32x4*)(dst + 4) = (f32x4){v[0][4], v[0][5], v[0][6], v[0][7]};
        } else if (gi < 17) {
          const bool isq = gi < 15; const float* gn = isq ? gq_norm : gk_norm;
          float ss = 0.f;
#pragma unroll
          for (int bj = 0; bj < 2; ++bj)
#pragma unroll
            for (int e = 0; e < 8; ++e) ss += v[bj][e] * v[bj][e];
          const float rn = rsqrtf(grp_sum(ss) * (1.f / 64.f) + EPS) * (isq ? 0.125f * LOG2E : 1.f);
          float kk = 0.f;
#pragma unroll
          for (int bj = 0; bj < 2; ++bj) {
            const unsigned ao = (unsigned)(bj == 0 ? (pos >> 6) : (pos & 63)) * 16 + 8 * (fq & 1);
            const f32x4 c0 = *(const f32x4*)(cos32 + ao), c1 = *(const f32x4*)(cos32 + ao + 4), s0 = *(const f32x4*)(sin32 + ao), s1 = *(const f32x4*)(sin32 + ao + 4);
#pragma unroll
            for (int e = 0; e < 8; ++e) {
              const float own = v[bj][e] * rn * gn[32 * bj + 8 * fq + e];
              const float oth = lane32_partner(own, lane);
              const float cc = e < 4 ? c0[e & 3] : c1[e & 3], sn = e < 4 ? s0[e & 3] : s1[e & 3];
              v[bj][e] = (fq < 2) ? own * cc - oth * sn : oth * sn + own * cc;
              kk += v[bj][e] * v[bj][e];
            }
          }
          bf16_t* dst = isq ? qd + ((unsigned)(bb * 8 + (gi - 7)) * S + pos) * 64 + 8 * fq : kd + ((unsigned)(bb * 2 + (gi - 15)) * S + pos) * 64 + 8 * fq;
          st8_bf16(dst, v[0]); st8_bf16(dst + 32, v[1]);
          if (!isq) kmx_run = fmaxf(kmx_run, grp_sum(kk));
        } else {
          bf16_t* dst = vtd + ((unsigned)(bb * 2 + (gi - 17)) * 64 + 8 * fq) * S + pos;
#pragma unroll
          for (int bj = 0; bj < 2; ++bj)
#pragma unroll
            for (int e = 0; e < 8; ++e) dst[(unsigned)(32 * bj + e) * S] = f2bf(v[bj][e]);
        }
        if (m & 1) asm volatile("" ::: "memory");
      }
    }
    if (gi == 15 || gi == 16) wave_atomic_max_pos(kmx_run, kmax2 + 32 + ((u.pm * 256) >> 13) * 2 + (gi - 15));
  }
};

template <int DQK, int DV>
__device__ __forceinline__ void attn_pass(const bf16_t* __restrict__ qh, const bf16_t* __restrict__ kh, const bf16_t* __restrict__ vth, int q0, char* smem, f32x16 (&o)[DV / 32], float kmax) {
  constexpr int KP = (DQK + 8) * 2, VP = 144, KSB = 64 * KP, VSB = DV * VP;
  constexpr int CK = DQK / 8, TKC = 64 * CK, NKC = (TKC + 511) / 512, NVC = DV / 64, NKS = DQK / 16, NEB = DV / 32, NT = S / 64;
  char* sK = smem; char* sV = smem + 2 * KSB;
  int tid = threadIdx.x; asm volatile("" : "+v"(tid));
  const int lane = tid & 63, wid = tid >> 6, r = lane & 31, h = lane >> 5;
  bf16x8 qf[NKS];
  {
    const bf16_t* qrow = qh + (size_t)(q0 + 32 * wid + r) * DQK + 8 * h;
#pragma unroll
    for (int ks = 0; ks < NKS; ++ks) qf[ks] = *(const bf16x8*)(qrow + 16 * ks);
  }
  int klo[NKC], vlo[NVC];
  const bf16_t* vg0 = vth + (size_t)(tid >> 3) * S + (tid & 7) * 8;
  const bool k1 = (TKC % 512 == 0) || (tid < TKC % 512);
#pragma unroll
  for (int j = 0; j < NKC; ++j) { const int c = tid + 512 * j; klo[j] = (c / CK) * KP + (c % CK) * 16; }
#pragma unroll
  for (int j = 0; j < NVC; ++j) { const int c = tid + 512 * j; vlo[j] = (c >> 3) * VP + (c & 7) * 16; }
  u32x4 rk[NKC], rv[NVC], rk1[NKC];
  const int rot = (int)((blockIdx.x >> 3) * 4u) & (NT - 1);
#define LOADK(dst, t) do { _Pragma("unroll") for (int j = 0; j < NKC; ++j) if (j == 0 || k1) dst[j] = *(const u32x4*)(kh + (size_t)(((t) + rot) & (NT - 1)) * 64 * DQK + (size_t)(tid + 512 * j) * 8); } while (0)
#define LOADV(dst, t) do { _Pragma("unroll") for (int j = 0; j < NVC; ++j) dst[j] = *(const u32x4*)(vg0 + (size_t)(64 * j) * S + (size_t)(((t) + rot) & (NT - 1)) * 64); } while (0)
#define STOREK(src, slot) do { _Pragma("unroll") for (int j = 0; j < NKC; ++j) if (j == 0 || k1) *(u32x4*)(sK + (slot) * KSB + klo[j]) = src[j]; } while (0)
#define STOREV(src, slot) do { _Pragma("unroll") for (int j = 0; j < NVC; ++j) *(u32x4*)(sV + (slot) * VSB + vlo[j]) = src[j]; } while (0)
  LOADK(rk, 0); LOADV(rv, 0); LOADK(rk1, 1);
#pragma unroll
  for (int eb = 0; eb < NEB; ++eb)
#pragma unroll
    for (int i = 0; i < 16; ++i) o[eb][i] = 0.f;
  float l_run = 0.f;
  f32x16 negm;
  {
    float qq = 0.f;
#pragma unroll
    for (int ks = 0; ks < NKS; ++ks)
#pragma unroll
      for (int j = 0; j < 8; ++j) { const float t = bf2f((unsigned short)qf[ks][j]); qq += t * t; }
    { auto rr = __builtin_amdgcn_permlane32_swap(__float_as_uint(qq), __float_as_uint(qq), false, false); qq = __uint_as_float(rr[0]) + __uint_as_float(rr[1]); }
    const float mref = sqrtf(qq) * kmax * 1.01f + 0.01f;
#pragma unroll
    for (int i = 0; i < 16; ++i) negm[i] = -mref;
  }
  __syncthreads();
  STOREK(rk, 0); STOREV(rv, 0); STOREK(rk1, 1);
  LOADK(rk, 2); LOADV(rv, 1);
  const int kofs = swz23(r) * KP + 16 * h, vofs = r * VP + 16 * h;
  __syncthreads();
  f32x16 sA, sB;
#define QKT(SD, slot) do { const char* kb0_ = sK + (slot) * KSB + kofs; \
    { const bf16x8 a0 = *(const bf16x8*)(kb0_), a1 = *(const bf16x8*)(kb0_ + 32 * KP); SD##0 = MFMA(a0, qf[0], negm); SD##1 = MFMA(a1, qf[0], negm); } \
    _Pragma("unroll") for (int ks = 1; ks < NKS; ++ks) { const bf16x8 a0 = *(const bf16x8*)(kb0_ + ks * 32), a1 = *(const bf16x8*)(kb0_ + 32 * KP + ks * 32); \
      SD##0 = MFMA(a0, qf[ks], SD##0); SD##1 = MFMA(a1, qf[ks], SD##1); } } while (0)
  f32x16 sA0, sA1, sB0, sB1;
  QKT(sA, 0);
#define STEP(SC, SN, t) do { \
    __syncthreads(); \
    if ((t) + 2 < NT) { STOREK(rk, (t) & 1); } \
    if ((t) + 1 < NT) { STOREV(rv, ((t) + 1) & 1); } \
    if ((t) + 3 < NT) { LOADK(rk, (t) + 3); } \
    if ((t) + 2 < NT) { LOADV(rv, (t) + 2); } \
    if ((t) + 1 < NT) { QKT(SN, ((t) + 1) & 1); } \
    float rsum0 = 0.f, rsum1 = 0.f; \
    _Pragma("unroll") for (int i = 0; i < 16; ++i) { SC##0[i] = fexp2(SC##0[i]); SC##1[i] = fexp2(SC##1[i]); rsum0 += SC##0[i]; rsum1 += SC##1[i]; } \
    l_run += rsum0 + rsum1; \
    bf16x8 pf[2][2]; \
    { u32x4 w; \
      w.x = pk2(SC##0[0], SC##0[1]); w.y = pk2(SC##0[2], SC##0[3]); w.z = pk2(SC##0[4], SC##0[5]); w.w = pk2(SC##0[6], SC##0[7]); pf[0][0] = __builtin_bit_cast(bf16x8, w); \
      w.x = pk2(SC##0[8], SC##0[9]); w.y = pk2(SC##0[10], SC##0[11]); w.z = pk2(SC##0[12], SC##0[13]); w.w = pk2(SC##0[14], SC##0[15]); pf[0][1] = __builtin_bit_cast(bf16x8, w); \
      w.x = pk2(SC##1[0], SC##1[1]); w.y = pk2(SC##1[2], SC##1[3]); w.z = pk2(SC##1[4], SC##1[5]); w.w = pk2(SC##1[6], SC##1[7]); pf[1][0] = __builtin_bit_cast(bf16x8, w); \
      w.x = pk2(SC##1[8], SC##1[9]); w.y = pk2(SC##1[10], SC##1[11]); w.z = pk2(SC##1[12], SC##1[13]); w.w = pk2(SC##1[14], SC##1[15]); pf[1][1] = __builtin_bit_cast(bf16x8, w); } \
    const char* vb0_ = sV + ((t) & 1) * VSB + vofs; \
    _Pragma("unroll") for (int kb = 0; kb < 2; ++kb) \
      _Pragma("unroll") for (int s2 = 0; s2 < 2; ++s2) \
        _Pragma("unroll") for (int eb = 0; eb < NEB; ++eb) { \
          const bf16x8 a = *(const bf16x8*)(vb0_ + eb * 32 * VP + (32 * kb + 16 * s2) * 2); \
          o[eb] = MFMA(a, pf[kb][s2], o[eb]); } \
  } while (0)
#pragma unroll
  for (int ks = 0; ks < NKS; ++ks) asm volatile("" :: "v"(qf[ks]));
#pragma unroll 1
  for (int kt = 0; kt < NT; kt += 2) {
    STEP(sA, sB, kt);
    STEP(sB, sA, kt + 1);
  }
#undef STEP
#undef QKT
#undef LOADK
#undef LOADV
#undef STOREK
#undef STOREV
  float ltot;
  { auto rr = __builtin_amdgcn_permlane32_swap(__float_as_uint(l_run), __float_as_uint(l_run), false, false); ltot = __uint_as_float(rr[0]) + __uint_as_float(rr[1]); }
  const float linv = frcp(ltot);
#pragma unroll
  for (int eb = 0; eb < NEB; ++eb)
#pragma unroll
    for (int i = 0; i < 16; ++i) o[eb][i] *= linv;
}

template <int DQK, int DV>
__device__ __forceinline__ void attn_pass2(const bf16_t* __restrict__ qh, const bf16_t* __restrict__ kh, const bf16_t* __restrict__ vth, int q0, char* smem, f32x16 (&o)[2][DV / 32], float kmax) {
  constexpr int KP = (DQK + 8) * 2, VP = 144, KSB = 64 * KP, VSB = DV * VP;
  constexpr int CK = DQK / 8, TKC = 64 * CK, NKC = (TKC + 511) / 512, NVC = DV / 64, NKS = DQK / 16, NEB = DV / 32, NT = S / 64;
  static_assert(TKC % 512 == 0, "attn_pass2: K tile must be a whole number of 512-thread passes");
  char* sK = smem; char* sV = smem + 2 * KSB;
  int tid = threadIdx.x; asm volatile("" : "+v"(tid));
  const int lane = tid & 63, wid = tid >> 6, r = lane & 31, h = lane >> 5;
  bf16x8 qf[2][NKS];
#pragma unroll
  for (int qb = 0; qb < 2; ++qb) {
    const bf16_t* qrow = qh + (size_t)(q0 + 64 * wid + 32 * qb + r) * DQK + 8 * h;
#pragma unroll
    for (int ks = 0; ks < NKS; ++ks) qf[qb][ks] = *(const bf16x8*)(qrow + 16 * ks);
  }
  int klo[NKC], vlo[NVC];
  const bf16_t* vg0 = vth + (size_t)(tid >> 3) * S + (tid & 7) * 8;
#pragma unroll
  for (int j = 0; j < NKC; ++j) { const int c = tid + 512 * j; klo[j] = (c / CK) * KP + (c % CK) * 16; }
#pragma unroll
  for (int j = 0; j < NVC; ++j) { const int c = tid + 512 * j; vlo[j] = (c >> 3) * VP + (c & 7) * 16; }
  u32x4 rk[NKC], rv[NVC];
  const int rot = (int)((blockIdx.x >> 3) * 4u) & (NT - 1);
#define LOADKV(t) do { \
    _Pragma("unroll") for (int j = 0; j < NKC; ++j) rk[j] = *(const u32x4*)(kh + (size_t)(((t) + rot) & (NT - 1)) * 64 * DQK + (size_t)(tid + 512 * j) * 8); \
    _Pragma("unroll") for (int j = 0; j < NVC; ++j) rv[j] = *(const u32x4*)(vg0 + (size_t)(64 * j) * S + (size_t)(((t) + rot) & (NT - 1)) * 64); } while (0)
#define STOREKV(slot) do { \
    _Pragma("unroll") for (int j = 0; j < NKC; ++j) *(u32x4*)(sK + (slot) * KSB + klo[j]) = rk[j]; \
    _Pragma("unroll") for (int j = 0; j < NVC; ++j) *(u32x4*)(sV + (slot) * VSB + vlo[j]) = rv[j]; } while (0)
  LOADKV(0);
#pragma unroll
  for (int qb = 0; qb < 2; ++qb)
#pragma unroll
    for (int eb = 0; eb < NEB; ++eb)
#pragma unroll
      for (int i = 0; i < 16; ++i) o[qb][eb][i] = 0.f;
  float l_run[2] = {0.f, 0.f}, mref[2];
#pragma unroll
  for (int qb = 0; qb < 2; ++qb) {
    float qq = 0.f;
#pragma unroll
    for (int ks = 0; ks < NKS; ++ks)
#pragma unroll
      for (int j = 0; j < 8; ++j) { const float t = bf2f((unsigned short)qf[qb][ks][j]); qq += t * t; }
    { auto rr = __builtin_amdgcn_permlane32_swap(__float_as_uint(qq), __float_as_uint(qq), false, false); qq = __uint_as_float(rr[0]) + __uint_as_float(rr[1]); }
    mref[qb] = sqrtf(qq) * kmax * 1.01f + 0.01f;
  }
  __syncthreads();
  STOREKV(0);
  LOADKV(1);
  const int kofs = swz23(r) * KP + 16 * h, vofs = r * VP + 16 * h;
#pragma unroll
  for (int qb = 0; qb < 2; ++qb)
#pragma unroll
    for (int ks = 0; ks < NKS; ++ks) asm volatile("" :: "v"(qf[qb][ks]));
#pragma unroll 1
  for (int kt = 0; kt < NT; ++kt) {
    const int cur = kt & 1;
    __syncthreads();
    if (kt + 1 < NT) { STOREKV(cur ^ 1); if (kt + 2 < NT) LOADKV(kt + 2); }
    f32x16 s[2][2];
    const char* kb0 = sK + cur * KSB + kofs;
#pragma unroll
    for (int ks = 0; ks < NKS; ++ks) {
      const bf16x8 a0 = *(const bf16x8*)(kb0 + ks * 32), a1 = *(const bf16x8*)(kb0 + 32 * KP + ks * 32);
#pragma unroll
      for (int qb = 0; qb < 2; ++qb) {
        if (ks == 0) {
          f32x16 z;
#pragma unroll
          for (int i = 0; i < 16; ++i) z[i] = -mref[qb];
          s[qb][0] = MFMA(a0, qf[qb][0], z); s[qb][1] = MFMA(a1, qf[qb][0], z);
        } else { s[qb][0] = MFMA(a0, qf[qb][ks], s[qb][0]); s[qb][1] = MFMA(a1, qf[qb][ks], s[qb][1]); }
      }
    }
    bf16x8 pf[2][2][2];
#pragma unroll
    for (int qb = 0; qb < 2; ++qb) {
      float rs0 = 0.f, rs1 = 0.f;
#pragma unroll
      for (int i = 0; i < 16; ++i) { s[qb][0][i] = fexp2(s[qb][0][i]); s[qb][1][i] = fexp2(s[qb][1][i]); rs0 += s[qb][0][i]; rs1 += s[qb][1][i]; }
      l_run[qb] += rs0 + rs1;
#pragma unroll
      for (int kb = 0; kb < 2; ++kb)
#pragma unroll
        for (int s2 = 0; s2 < 2; ++s2) {
          u32x4 w;
          w.x = pk2(s[qb][kb][8 * s2 + 0], s[qb][kb][8 * s2 + 1]); w.y = pk2(s[qb][kb][8 * s2 + 2], s[qb][kb][8 * s2 + 3]);
          w.z = pk2(s[qb][kb][8 * s2 + 4], s[qb][kb][8 * s2 + 5]); w.w = pk2(s[qb][kb][8 * s2 + 6], s[qb][kb][8 * s2 + 7]);
          pf[qb][kb][s2] = __builtin_bit_cast(bf16x8, w);
        }
    }
    const char* vb0 = sV + cur * VSB + vofs;
#pragma unroll
    for (int kb = 0; kb < 2; ++kb)
#pragma unroll
      for (int s2 = 0; s2 < 2; ++s2)
#pragma unroll
        for (int eb = 0; eb < NEB; ++eb) {
          const bf16x8 a = *(const bf16x8*)(vb0 + eb * 32 * VP + (32 * kb + 16 * s2) * 2);
#pragma unroll
          for (int qb = 0; qb < 2; ++qb) o[qb][eb] = MFMA(a, pf[qb][kb][s2], o[qb][eb]);
        }
  }
#undef LOADKV
#undef STOREKV
#pragma unroll
  for (int qb = 0; qb < 2; ++qb) {
    float ltot;
    { auto rr = __builtin_amdgcn_permlane32_swap(__float_as_uint(l_run[qb]), __float_as_uint(l_run[qb]), false, false); ltot = __uint_as_float(rr[0]) + __uint_as_float(rr[1]); }
    const float linv = frcp(ltot);
#pragma unroll
    for (int eb = 0; eb < NEB; ++eb)
#pragma unroll
      for (int i = 0; i < 16; ++i) o[qb][eb][i] *= linv;
  }
}

__device__ __forceinline__ void store_o64(bf16_t* dst, const f32x16 (&o)[2], int h) {
#pragma unroll
  for (int eb = 0; eb < 2; ++eb)
#pragma unroll
    for (int i4 = 0; i4 < 4; ++i4) { u32x2 w; w.x = pk2(o[eb][4 * i4], o[eb][4 * i4 + 1]); w.y = pk2(o[eb][4 * i4 + 2], o[eb][4 * i4 + 3]); *(u32x2*)(dst + 32 * eb + 8 * i4 + 4 * h) = w; }
}

__device__ __forceinline__ int srccol(int mapid, int b) {
  if (mapid >= 5) { const int pn = b >> 3, bj = (b >> 2) & 1, wc = b & 3; return srccol(mapid == 5 ? 0 : 2, 2 * (4 * pn + wc) + bj); }
  if (mapid == 0) return 32 * b;
  if (mapid == 1) { const int pn = b >> 3, w = b & 7; return ((w >> 2) ? 2816 : 0) + 128 * pn + 32 * (w & 3); }
  if (mapid == 2) { if (b < 13) return 32 * b; if (b == 13) return -1; if (b < 38) return 416 + 32 * (b - 14); return -1; }
  const int hd = b >> 2, sub = b & 3; return sub < 3 ? hd * 96 + 32 * sub : -1;
}
__device__ __forceinline__ unsigned pk2h(float lo, float hi) { typedef _Float16 h2_t __attribute__((ext_vector_type(2))); const h2_t v = {(_Float16)lo, (_Float16)hi}; return __builtin_bit_cast(unsigned, v); }
template <int KB, bool F16 = false>
__device__ __forceinline__ void conv_matrix(const float* __restrict__ src, int ldsrc, int K, bf16_t* __restrict__ dst, int nblk, int mapid, const float* __restrict__ gain, float* tile, int wb = -1, int wn = 0) {
  if (wb < 0) { wb = blockIdx.x; wn = gridDim.x; }
  const int kblks = K / KB, nunits = (nblk >> 1) * kblks; int tid = threadIdx.x; asm volatile("" : "+v"(tid));
#pragma unroll 1
  for (int u = wb; u < nunits; u += wn) {
    const int nb = u / kblks, kb = u % kblks;
    const int c = tid & 63, kr = tid >> 6;
    const int sc = srccol(mapid, nb * 2 + (c >> 5));
    float v[KB / 8];
    if (sc >= 0) {
      const float* sp = src + (size_t)(kb * KB + kr) * ldsrc + sc + (c & 31);
#pragma unroll
      for (int p = 0; p < KB / 8; ++p) v[p] = sp[(size_t)(p * 8) * ldsrc];
      if (gain) {
#pragma unroll
        for (int p = 0; p < KB / 8; ++p) v[p] *= gain[kb * KB + p * 8 + kr];
      }
    } else {
#pragma unroll
      for (int p = 0; p < KB / 8; ++p) v[p] = 0.f;
    }
    __syncthreads();
#pragma unroll
    for (int p = 0; p < KB / 8; ++p) tile[(p * 8 + kr) * 65 + c] = v[p];
    __syncthreads();
    const int nr = tid >> 3, kc = tid & 7;
#pragma unroll
    for (int q = 0; q < KB / 64; ++q) {
      const float* tp = tile + (q * 64 + kc * 8) * 65 + nr;
      u32x4 w;
      if constexpr (F16) { w.x = pk2h(tp[0], tp[65]); w.y = pk2h(tp[130], tp[195]); w.z = pk2h(tp[260], tp[325]); w.w = pk2h(tp[390], tp[455]); }
      else { w.x = pk2(tp[0], tp[65]); w.y = pk2(tp[130], tp[195]); w.z = pk2(tp[260], tp[325]); w.w = pk2(tp[390], tp[455]); }
      *(u32x4*)(dst + (size_t)(nb * 64 + nr) * K + kb * KB + q * 64 + kc * 8) = w;
    }
  }
}

#define XB_TMO      128
#define XB_XCNT(j)  (256  + 64 * (j))
#define XB_XSUB(j)  (1280 + 64 * (j))
#define XB_XGEN(j)  (2304 + 64 * (j))
#define XB_TOP      3328
#define XB_TOPGEN   3392
#define XCD_BAR_WORDS 3456
#define XB_SPIN_CAP (1u << 18)
#define LAS __attribute__((address_space(3)))
__device__ __forceinline__ unsigned xb_ld(unsigned* p)              { return __hip_atomic_load(p, __ATOMIC_RELAXED, __HIP_MEMORY_SCOPE_AGENT); }
__device__ __forceinline__ unsigned xb_add(unsigned* p, unsigned v) { return __hip_atomic_fetch_add(p, v, __ATOMIC_RELAXED, __HIP_MEMORY_SCOPE_AGENT); }
__device__ __forceinline__ unsigned xb_xcc_id() { return (unsigned)__builtin_amdgcn_s_getreg((3 << 11) | 20) & 0xFu; }
#define XB_SPIN(cond, bar) do { unsigned _sp = 0; while (cond) { __builtin_amdgcn_s_sleep(1); \
    if ((++_sp & 255u) == 0u) { if (xb_ld(&(bar)[XB_TMO])) break; if (_sp > XB_SPIN_CAP) { atomicAdd(&(bar)[XB_TMO], 1u); break; } } } } while (0)
struct XcdBarrier { unsigned* bar; unsigned x; volatile LAS unsigned* st; };
__device__ __forceinline__ XcdBarrier xcd_barrier_post(unsigned* bar, volatile LAS unsigned* st) {
    XcdBarrier b; b.bar = bar; b.x = xb_xcc_id(); b.st = st;
    if (threadIdx.x == 0) (void)xb_add(&bar[XB_XCNT(b.x)], 1u);
    return b;
}
__device__ __forceinline__ void xcd_barrier_complete(unsigned* bar, unsigned x, unsigned& nloc, unsigned& nx) {
    const unsigned G = gridDim.x * gridDim.y * gridDim.z;
    unsigned sum, cnt, mine, sp = 0u;
    for (;;) {
        sum = 0u; cnt = 0u; mine = 0u;
#pragma unroll
        for (unsigned j = 0; j < 16; ++j) { const unsigned c = xb_ld(&bar[XB_XCNT(j)]); sum += c; cnt += (c > 0u) ? 1u : 0u; mine = (j == x) ? c : mine; }
        if (sum == G) break;
        __builtin_amdgcn_s_sleep(1);
        if ((++sp & 255u) == 0u) { if (xb_ld(&bar[XB_TMO])) break; if (sp > XB_SPIN_CAP) { atomicAdd(&bar[XB_TMO], 1u); break; } }
    }
    nloc = mine > 0u ? mine : 1u; nx = cnt > 0u ? cnt : 1u;
}
__device__ __forceinline__ void xcd_barrier(const XcdBarrier& b) {
    asm volatile("s_waitcnt vmcnt(0)" ::: "memory");
    __syncthreads();
    if (threadIdx.x == 0) {
        unsigned* bar = b.bar;
        __builtin_amdgcn_s_waitcnt(0);
        unsigned nloc = b.st[0], nx = b.st[1];
        if (nloc == 0u) { xcd_barrier_complete(bar, b.x, nloc, nx); b.st[0] = nloc; b.st[1] = nx; }
        const unsigned old = xb_add(&bar[XB_XSUB(b.x)], 1u);
        const unsigned gen = old / nloc;
        if (old + 1u == (gen + 1u) * nloc) {
            __builtin_amdgcn_fence(__ATOMIC_RELEASE, "agent");
            asm volatile("s_waitcnt vmcnt(0)" ::: "memory");
            const unsigned og = xb_add(&bar[XB_TOP], 1u);
            const unsigned tg = og / nx;
            if (og + 1u == (tg + 1u) * nx) xb_add(&bar[XB_TOPGEN], 1u);
            else XB_SPIN(xb_ld(&bar[XB_TOPGEN]) == tg, bar);
            __builtin_amdgcn_fence(__ATOMIC_ACQUIRE, "agent");
            xb_add(&bar[XB_XGEN(b.x)], 1u);
            asm volatile("s_waitcnt vmcnt(0)" ::: "memory");
        } else {
            XB_SPIN(xb_ld(&bar[XB_XGEN(b.x)]) == gen, bar);
            __builtin_amdgcn_fence(__ATOMIC_ACQUIRE, "agent");
            asm volatile("s_waitcnt vmcnt(0)" ::: "memory");
        }
    }
    __syncthreads();
}

__global__ void __launch_bounds__(512, 2) mega_fwd(Params p_arg) {
  typedef const __attribute__((address_space(4))) Params* KParamsPtr;
  KParamsPtr pptr = (KParamsPtr)__builtin_amdgcn_kernarg_segment_ptr(); asm volatile("" : "+s"(pptr));
  const __attribute__((address_space(4))) Params& p = *pptr;
  __shared__ __attribute__((aligned(16))) char smem[147456 + 16];
  cg::grid_group grid = cg::this_grid();
  if (p.flags) grid.sync();
  if (threadIdx.x == 0) { *(volatile LAS unsigned*)(smem + 147456) = 0u; *(volatile LAS unsigned*)(smem + 147460) = 0u; }
  __syncthreads();
  const XcdBarrier xbar = xcd_barrier_post((unsigned*)(p.ws + O_CTL), (volatile LAS unsigned*)(smem + 147456));
  char* ws = p.ws;
  float* cos64 = (float*)(ws + O_COS64); float* sin64 = (float*)(ws + O_SIN64);
  float* cos32 = (float*)(ws + O_COS32); float* sin32 = (float*)(ws + O_SIN32);
  float* ssq = (float*)(ws + O_SSQ); float* ssq2 = (float*)(ws + O_SSQ2); float* kpe = (float*)(ws + O_KPE);
  bf16_t* xb = (bf16_t*)(ws + O_XB); bf16_t* hbuf = (bf16_t*)(ws + O_H); bf16_t* mix = (bf16_t*)p.out; _Float16* x16 = (_Float16*)(ws + O_X16);
  const int G = gridDim.x;

  {
    float* tile = (float*)smem;
    const bool defer = (G == 256);
    for (int l = 0; l < (defer ? 1 : 2); ++l) {
      conv_matrix<256, true>(p.ffn1_w_gu + (size_t)l * 1024 * 5632, 5632, 1024, (bf16_t*)(ws + O_WGU + (size_t)(2 * l) * SZ_WGU), 176, 1, p.ffn1_norm + l * 1024, tile);
      conv_matrix<256, true>(p.ffn2_w_gu + (size_t)l * 1024 * 5632, 5632, 1024, (bf16_t*)(ws + O_WGU + (size_t)(2 * l + 1) * SZ_WGU), 176, 1, p.ffn2_norm + l * 1024, tile);
      conv_matrix<256>(p.ffn1_w_down + (size_t)l * 2816 * 1024, 1024, 2816, (bf16_t*)(ws + O_WDN + (size_t)(2 * l) * SZ_WDN), 32, 0, nullptr, tile);
      conv_matrix<256>(p.ffn2_w_down + (size_t)l * 2816 * 1024, 1024, 2816, (bf16_t*)(ws + O_WDN + (size_t)(2 * l + 1) * SZ_WDN), 32, 0, nullptr, tile);
    }
    conv_matrix<256, true>(p.ev_w_in, 2560, 1024, (bf16_t*)(ws + O_WEVIN), 80, 5, p.ev_norm, tile);
    conv_matrix<256>(p.ev_w_out, 1024, 1024, (bf16_t*)(ws + O_WEVOUT), 32, 0, nullptr, tile);
    if (!defer) {
      conv_matrix<256, true>(p.od_w_in, 1184, 1024, (bf16_t*)(ws + O_WODIN), 40, 6, p.od_norm, tile);
      conv_matrix<256>(p.od_w_uq, 768, 256, (bf16_t*)(ws + O_WUQ), 32, 3, p.od_cq_norm, tile);
      conv_matrix<128>(p.od_w_ukv, 1024, 128, (bf16_t*)(ws + O_WUKV), 32, 0, p.od_ckv_norm, tile);
      conv_matrix<256>(p.od_w_out, 1024, 1024, (bf16_t*)(ws + O_WODOUT), 32, 0, nullptr, tile);
    }
    int tid = threadIdx.x; asm volatile("" : "+v"(tid));
    const int lane = tid & 63, wid = tid >> 6;
    const int gt = blockIdx.x * 512 + tid, nth = G * 512;
    { bf16_t* wss = (bf16_t*)(ws + O_WSS);
      for (int i = gt; i < 8 * 128 * 128 / 4; i += nth) { const f32x4 v = *(const f32x4*)(p.ev_w_s + (size_t)i * 4); u32x2 w; w.x = pk2(v[0], v[1]); w.y = pk2(v[2], v[3]); *(u32x2*)(wss + (size_t)i * 4) = w; } }
    for (int i = gt; i < 8192 * 32; i += nth) {
      const int pp = i >> 5, d = i & 31; const float inv = (float)exp2(-(double)d * (13.287712379549449 / 32.0)); const float ang = (float)pp * inv;
      cos64[i] = (float)cos((double)ang); sin64[i] = (float)sin((double)ang);
    }
    for (int i = gt; i < 8192 * 16; i += nth) {
      const int pp = i >> 4, d = i & 15; const float inv = (float)exp2(-(double)d * (13.287712379549449 / 16.0)); const float ang = (float)pp * inv;
      cos32[i] = (float)cos((double)ang); sin32[i] = (float)sin((double)ang);
    }
    for (int row = blockIdx.x * 8 + wid; row < T; row += G * 8) {
      const float* xr = p.x + (size_t)row * DM + lane * 16; float ss = 0.f; u32x4 w0, w1;
      const f32x4 a = *(const f32x4*)(xr), b = *(const f32x4*)(xr + 4), c = *(const f32x4*)(xr + 8), d = *(const f32x4*)(xr + 12);
      ss = (a[0] * a[0] + a[1] * a[1] + a[2] * a[2] + a[3] * a[3]) + (b[0] * b[0] + b[1] * b[1] + b[2] * b[2] + b[3] * b[3]) + (c[0] * c[0] + c[1] * c[1] + c[2] * c[2] + c[3] * c[3]) + (d[0] * d[0] + d[1] * d[1] + d[2] * d[2] + d[3] * d[3]);
      w0.x = pk2(a[0], a[1]); w0.y = pk2(a[2], a[3]); w0.z = pk2(b[0], b[1]); w0.w = pk2(b[2], b[3]);
      w1.x = pk2(c[0], c[1]); w1.y = pk2(c[2], c[3]); w1.z = pk2(d[0], d[1]); w1.w = pk2(d[2], d[3]);
      { typedef _Float16 h8_t __attribute__((ext_vector_type(8))); typedef float f8_t __attribute__((ext_vector_type(8)));
        const f8_t f0 = {a[0], a[1], a[2], a[3], b[0], b[1], b[2], b[3]}, f1 = {c[0], c[1], c[2], c[3], d[0], d[1], d[2], d[3]};
        *(h8_t*)(x16 + (size_t)row * DM + lane * 16) = __builtin_convertvector(f0, h8_t); *(h8_t*)(x16 + (size_t)row * DM + lane * 16 + 8) = __builtin_convertvector(f1, h8_t); }
      ss += __shfl_xor(ss, 1); ss += __shfl_xor(ss, 2);
      if ((lane & 3) == 0) ssq[(size_t)row * 16 + (lane >> 2)] = ss;
    }
  }
  xcd_barrier(xbar);

  auto layer_body = [&](auto LC) __attribute__((always_inline)) {
    constexpr int l = decltype(LC)::value;
    { pg8::Gemm g{(const bf16_t*)x16, (const bf16_t*)(ws + O_WGU + (size_t)(2 * l) * SZ_WGU), T, 5632, 1024}; pg8::StaticOrder so; so.init(T, 5632, (int)gridDim.x, (int)blockIdx.x); EpiGU8 e{ssq, hbuf};
      pg8::gemm_phase<EpiGU8, pg8::StaticOrder, true, true, true>((PG8_LAS unsigned char*)smem, g, so, e); }
    if constexpr (l == 0) {
      if (G == 256 && blockIdx.x >= 128) {
        float* tile = (float*)smem; const int wb = (int)blockIdx.x - 128;
        conv_matrix<256, true>(p.ffn1_w_gu + (size_t)1024 * 5632, 5632, 1024, (bf16_t*)(ws + O_WGU + (size_t)2 * SZ_WGU), 176, 1, p.ffn1_norm + 1024, tile, wb, 128);
        conv_matrix<256>(p.ffn1_w_down + (size_t)2816 * 1024, 1024, 2816, (bf16_t*)(ws + O_WDN + (size_t)2 * SZ_WDN), 32, 0, nullptr, tile, wb, 128);
        conv_matrix<256, true>(p.od_w_in, 1184, 1024, (bf16_t*)(ws + O_WODIN), 40, 6, p.od_norm, tile, wb, 128);
        conv_matrix<256>(p.od_w_uq, 768, 256, (bf16_t*)(ws + O_WUQ), 32, 3, p.od_cq_norm, tile, wb, 128);
        conv_matrix<128>(p.od_w_ukv, 1024, 128, (bf16_t*)(ws + O_WUKV), 32, 0, p.od_ckv_norm, tile, wb, 128);
      }
    }
    xcd_barrier(xbar);
    { pg8::Gemm g{hbuf, (const bf16_t*)(ws + O_WDN + (size_t)(2 * l) * SZ_WDN), T, 1024, 2816}; pg8::StaticOrder so; so.init(T, 1024, (int)gridDim.x, (int)blockIdx.x); EpiRes8 e{x16, p.out, xb, ssq, 0.5f, 1};
      pg8::gemm_phase<EpiRes8, pg8::StaticOrder, false, true>((PG8_LAS unsigned char*)smem, g, so, e); }
    xcd_barrier(xbar);
    if constexpr (l == 0) {
      bf16_t* ub = (bf16_t*)(ws + O_U); bf16_t* vt = (bf16_t*)(ws + O_VT); bf16_t* qb = (bf16_t*)(ws + O_QB); bf16_t* kb = (bf16_t*)(ws + O_KB); bf16_t* vtb = (bf16_t*)(ws + O_VTB);
      { pg8::Gemm g{(const bf16_t*)x16, (const bf16_t*)(ws + O_WEVIN), T, 2560, 1024}; pg8::StaticOrder so; so.init(T, 2560, (int)gridDim.x, (int)blockIdx.x);
        EpiEvIn8 e{ssq, p.ev_sgu_norm, p.ev_q_norm, p.ev_k_norm, cos64, sin64, ub, vt, qb, kb, vtb, (unsigned*)(ws + O_KMAX)};
        pg8::gemm_phase<EpiEvIn8, pg8::StaticOrder, true, true, true>((PG8_LAS unsigned char*)smem, g, so, e); }
      xcd_barrier(xbar);
      { EpiGmlp e{p.ev_b_s, ub, mix}; gemm_phase<false, 1>((const bf16_t*)(ws + O_WSS), 128, 1, vt, 128, 128, smem, e); }
      {
        float d1 = 0.f, d2 = 0.f;
        for (int i = 0; i < 64; ++i) { d1 += p.ev_lam_q1[i] * p.ev_lam_k1[i]; d2 += p.ev_lam_q2[i] * p.ev_lam_k2[i]; }
        const float lam_init = 0.2f, lam = expf(d1) - expf(d2) + lam_init;
        int tid = threadIdx.x; asm volatile("" : "+v"(tid));
        const int lane = tid & 63, wid = tid >> 6, r = lane & 31, h = lane >> 5;
        const unsigned* kmx = (const unsigned*)(ws + O_KMAX);
#pragma unroll 1
        for (int u = blockIdx.x; u < 256; u += G) {
          const int bh = u & 7, qt = u >> 3, bb = bh >> 2, hd = bh & 3;
          const bf16_t* vth = vtb + (size_t)(bb * 4 + hd) * 128 * S;
          f32x16 o[4];
          const int tok = bb * S + qt * 256 + 32 * wid + r;
          bf16_t* dst = mix + (size_t)tok * DM + 512 + hd * 128;
          attn_pass<64, 128>(qb + (size_t)(bb * 8 + hd * 2) * S * 64, kb + (size_t)(bb * 8 + hd * 2) * S * 64, vth, qt * 256, smem, o, kmax_of(kmx, bb * 8 + hd * 2));
#pragma unroll
          for (int eb = 0; eb < 4; ++eb)
#pragma unroll
            for (int i4 = 0; i4 < 4; ++i4) { u32x2 w; w.x = pk2(o[eb][4 * i4], o[eb][4 * i4 + 1]); w.y = pk2(o[eb][4 * i4 + 2], o[eb][4 * i4 + 3]); *(u32x2*)(dst + 32 * eb + 8 * i4 + 4 * h) = w; }
          attn_pass<64, 128>(qb + (size_t)(bb * 8 + hd * 2 + 1) * S * 64, kb + (size_t)(bb * 8 + hd * 2 + 1) * S * 64, vth, qt * 256, smem, o, kmax_of(kmx, bb * 8 + hd * 2 + 1));
          float ss = 0.f;
#pragma unroll
          for (int eb = 0; eb < 4; ++eb)
#pragma unroll
            for (int i4 = 0; i4 < 4; ++i4) {
              const u32x2 w = *(const volatile u32x2*)(dst + 32 * eb + 8 * i4 + 4 * h);
              const float a0 = __builtin_bit_cast(float, w.x << 16), a1 = __builtin_bit_cast(float, w.x & 0xffff0000u);
              const float a2 = __builtin_bit_cast(float, w.y << 16), a3 = __builtin_bit_cast(float, w.y & 0xffff0000u);
              o[eb][4 * i4] = a0 - lam * o[eb][4 * i4]; o[eb][4 * i4 + 1] = a1 - lam * o[eb][4 * i4 + 1];
              o[eb][4 * i4 + 2] = a2 - lam * o[eb][4 * i4 + 2]; o[eb][4 * i4 + 3] = a3 - lam * o[eb][4 * i4 + 3];
              ss += (o[eb][4 * i4] * o[eb][4 * i4] + o[eb][4 * i4 + 1] * o[eb][4 * i4 + 1]) + (o[eb][4 * i4 + 2] * o[eb][4 * i4 + 2] + o[eb][4 * i4 + 3] * o[eb][4 * i4 + 3]);
            }
          ss += __shfl_xor(ss, 32);
          const float rn = rsqrtf(ss * (1.f / 128.f) + EPS) * (1.f - lam_init);
#pragma unroll
          for (int eb = 0; eb < 4; ++eb)
#pragma unroll
            for (int i4 = 0; i4 < 4; ++i4) {
              float v[4];
#pragma unroll
              for (int c = 0; c < 4; ++c) v[c] = o[eb][4 * i4 + c] * rn * p.ev_sub_norm[32 * eb + 8 * i4 + 4 * h + c];
              u32x2 w; w.x = pk2(v[0], v[1]); w.y = pk2(v[2], v[3]);
              *(u32x2*)(dst + 32 * eb + 8 * i4 + 4 * h) = w;
            }
        }
      }
      xcd_barrier(xbar);
      { pg8::Gemm g{mix, (const bf16_t*)(ws + O_WEVOUT), T, 1024, 1024}; pg8::StaticOrder so; so.init(T, 1024, (int)gridDim.x, (int)blockIdx.x); EpiRes8 e{x16, p.out, xb, ssq, 1.0f, 1};
        pg8::gemm_phase<EpiRes8, pg8::StaticOrder, false, true>((PG8_LAS unsigned char*)smem, g, so, e); }
      xcd_barrier(xbar);
    } else {
      bf16_t* cq = (bf16_t*)(ws + O_CQ); bf16_t* ckv = (bf16_t*)(ws + O_CKV); bf16_t* qc = (bf16_t*)(ws + O_QC); bf16_t* kc = (bf16_t*)(ws + O_KC);
      bf16_t* vtc = (bf16_t*)(ws + O_VTC); bf16_t* qd = (bf16_t*)(ws + O_QD); bf16_t* kd = (bf16_t*)(ws + O_KD); bf16_t* vtd = (bf16_t*)(ws + O_VTD);
      { pg8::Gemm g{(const bf16_t*)x16, (const bf16_t*)(ws + O_WODIN), T, 1280, 1024}; pg8::StaticOrder so; so.init(T, 1280, (int)gridDim.x, (int)blockIdx.x);
        EpiOdIn8 e{ssq, p.od_gqa_q_norm, p.od_gqa_k_norm, cos32, sin32, cq, ckv, ssq2, kpe, qd, kd, vtd, (unsigned*)(ws + O_KMAX)};
        pg8::gemm_phase<EpiOdIn8, pg8::StaticOrder, true, true, true, true>((PG8_LAS unsigned char*)smem, g, so, e); }
      xcd_barrier(xbar);
      { EpiUq e{ssq2, p.od_mla_q_norm, cos32, sin32, qc}; gemm_phase<true, 0>((const bf16_t*)(ws + O_WUQ), 256, 4, cq, 256, 256, smem, e); }
      { EpiUkv e{ssq2, p.od_mla_k_norm, kpe, cos32, sin32, kc, vtc, (unsigned*)(ws + O_KMAX)}; gemm_phase<false, 0>((const bf16_t*)(ws + O_WUKV), 128, 4, ckv, 128, 128, smem, e); }
      xcd_barrier(xbar);
      {
        int tid = threadIdx.x; asm volatile("" : "+v"(tid));
        const int lane = tid & 63, wid = tid >> 6, r = lane & 31, h = lane >> 5;
        const unsigned* kmx = (const unsigned*)(ws + O_KMAX);
#pragma unroll 1
        for (int u = blockIdx.x; u < 768; u += G) {
          if (u < 512) {
            f32x16 o[2];
            const int bh = u & 15, qt = u >> 4, bb = bh >> 3, hh = bh & 7;
            const int tok = bb * S + qt * 256 + 32 * wid + r;
            attn_pass<96, 64>(qc + (size_t)(bb * 8 + hh) * S * 96, kc + (size_t)(bb * 8 + hh) * S * 96, vtc + (size_t)(bb * 8 + hh) * 64 * S, qt * 256, smem, o, kmax_of(kmx, 16 + bb * 8 + hh));
            store_o64(mix + (size_t)tok * DM + hh * 64, o, h);
          } else {
            f32x16 o2[2][2];
            const int uu = u - 512, bh = uu & 15, qt = uu >> 4, bb = bh >> 3, hh = bh & 7, kvh = hh >> 2;
            attn_pass2<64, 64>(qd + (size_t)(bb * 8 + hh) * S * 64, kd + (size_t)(bb * 2 + kvh) * S * 64, vtd + (size_t)(bb * 2 + kvh) * 64 * S, qt * 512, smem, o2, kmax_of(kmx, 32 + bb * 2 + kvh));
#pragma unroll
            for (int qb = 0; qb < 2; ++qb) {
              const int tok = bb * S + qt * 512 + 64 * wid + 32 * qb + r;
              store_o64(mix + (size_t)tok * DM + 512 + hh * 64, o2[qb], h);
            }
          }
        }
      }
      xcd_barrier(xbar);
      { pg8::Gemm g{mix, (const bf16_t*)(ws + O_WODOUT), T, 1024, 1024}; pg8::StaticOrder so; so.init(T, 1024, (int)gridDim.x, (int)blockIdx.x); EpiRes8 e{x16, p.out, xb, ssq, 1.0f, 1};
        pg8::gemm_phase<EpiRes8, pg8::StaticOrder, false, true>((PG8_LAS unsigned char*)smem, g, so, e); }
      xcd_barrier(xbar);
    }
    { pg8::Gemm g{(const bf16_t*)x16, (const bf16_t*)(ws + O_WGU + (size_t)(2 * l + 1) * SZ_WGU), T, 5632, 1024}; pg8::StaticOrder so; so.init(T, 5632, (int)gridDim.x, (int)blockIdx.x); EpiGU8 e{ssq, hbuf};
      pg8::gemm_phase<EpiGU8, pg8::StaticOrder, true, true, true>((PG8_LAS unsigned char*)smem, g, so, e); }
    if constexpr (l == 0) {
      if (G == 256 && blockIdx.x >= 128) {
        float* tile = (float*)smem; const int wb = (int)blockIdx.x - 128;
        conv_matrix<256, true>(p.ffn2_w_gu + (size_t)1024 * 5632, 5632, 1024, (bf16_t*)(ws + O_WGU + (size_t)3 * SZ_WGU), 176, 1, p.ffn2_norm + 1024, tile, wb, 128);
        conv_matrix<256>(p.ffn2_w_down + (size_t)2816 * 1024, 1024, 2816, (bf16_t*)(ws + O_WDN + (size_t)3 * SZ_WDN), 32, 0, nullptr, tile, wb, 128);
        conv_matrix<256>(p.od_w_out, 1024, 1024, (bf16_t*)(ws + O_WODOUT), 32, 0, nullptr, tile, wb, 128);
      }
    }
    xcd_barrier(xbar);
    { pg8::Gemm g{hbuf, (const bf16_t*)(ws + O_WDN + (size_t)(2 * l + 1) * SZ_WDN), T, 1024, 2816}; pg8::StaticOrder so; so.init(T, 1024, (int)gridDim.x, (int)blockIdx.x); EpiRes8 e{x16, p.out, xb, ssq, 0.5f, l == 0 ? 1 : 0};
      pg8::gemm_phase<EpiRes8, pg8::StaticOrder, false, true>((PG8_LAS unsigned char*)smem, g, so, e); }
    if (l == 0) xcd_barrier(xbar);
  };
  layer_body(std::integral_constant<int, 0>{});
  layer_body(std::integral_constant<int, 1>{});
}

extern "C" void kernel_launch(void* const* d_in, const int* in_sizes, int n_in, void* d_out, int out_size, void* d_ws, size_t ws_size, hipStream_t stream) {
  static int grid_blocks = 0;
  if (!grid_blocks) {
    int dev = 0, cus = 0, per_cu = 0;
    hipGetDevice(&dev);
    hipDeviceGetAttribute(&cus, hipDeviceAttributeMultiprocessorCount, dev);
    hipOccupancyMaxActiveBlocksPerMultiprocessor(&per_cu, mega_fwd, 512, 0);
    if (per_cu > 1) per_cu = 1;
    if (per_cu < 1) per_cu = 1;
    grid_blocks = cus * per_cu;
  }
  Params p{};
  const float** pp = (const float**)&p;
  for (int i = 0; i < 31; ++i) pp[i] = (const float*)d_in[i];
  p.out = (float*)d_out; p.ws = (char*)d_ws;
  hipMemsetAsync(d_ws, 0, 16384, stream);
  void* args[] = {&p};
  hipError_t e = hipLaunchCooperativeKernel((void*)mega_fwd, dim3(grid_blocks), dim3(512), args, 0, stream);
  if (e != hipSuccess) fprintf(stderr, "cooperative launch failed: %s (grid %d)\n", hipGetErrorString(e), grid_blocks);
}
```

```cpp
#include <hip/hip_runtime.h>
#include <hip/hip_cooperative_groups.h>
#include <stdint.h>
#include <stdio.h>
#include <type_traits>
namespace cg = cooperative_groups;

typedef unsigned short bf16_t;
typedef __attribute__((ext_vector_type(8))) short bf16x8;
typedef __attribute__((ext_vector_type(16))) float f32x16;
typedef __attribute__((ext_vector_type(4))) float f32x4;
typedef __attribute__((ext_vector_type(4))) unsigned u32x4;
typedef __attribute__((ext_vector_type(2))) unsigned u32x2;
typedef float f32x2_t __attribute__((ext_vector_type(2)));
typedef __bf16 bf16x2_t __attribute__((ext_vector_type(2)));

constexpr int T = 16384, S = 8192, DM = 1024, DFF = 2816;
constexpr float EPS = 1e-6f;
constexpr float LOG2E = 1.4426950408889634f;

constexpr size_t O_CTL = 0;
constexpr size_t O_COS64 = 16384;
constexpr size_t O_SIN64 = O_COS64 + (size_t)8192 * 32 * 4;
constexpr size_t O_COS32 = O_SIN64 + (size_t)8192 * 32 * 4;
constexpr size_t O_SIN32 = O_COS32 + (size_t)8192 * 16 * 4;
constexpr size_t O_SSQ = O_SIN32 + (size_t)8192 * 16 * 4;
constexpr size_t O_SSQ2 = O_SSQ + (size_t)T * 16 * 4;
constexpr size_t O_KPE = O_SSQ2 + (size_t)T * 8 * 4;
constexpr size_t O_WGU = O_KPE + (size_t)T * 32 * 4;
constexpr size_t SZ_WGU = (size_t)5632 * 1024 * 2;
constexpr size_t O_WDN = O_WGU + 4 * SZ_WGU;
constexpr size_t SZ_WDN = (size_t)1024 * 2816 * 2;
constexpr size_t O_WEVIN = O_WDN + 4 * SZ_WDN;
constexpr size_t O_WEVOUT = O_WEVIN + (size_t)2560 * 1024 * 2;
constexpr size_t O_WODIN = O_WEVOUT + (size_t)1024 * 1024 * 2;
constexpr size_t O_WUQ = O_WODIN + (size_t)1280 * 1024 * 2;
constexpr size_t O_WUKV = O_WUQ + (size_t)1024 * 256 * 2;
constexpr size_t O_WODOUT = O_WUKV + (size_t)1024 * 128 * 2;
constexpr size_t O_WSS = O_WODOUT + (size_t)1024 * 1024 * 2;
constexpr size_t O_XB = O_WSS + (size_t)8 * 128 * 128 * 2;
constexpr size_t O_X16 = O_XB + (size_t)T * 1024 * 2;
constexpr size_t O_BIG = O_X16 + (size_t)T * 1024 * 2;
constexpr size_t O_H = O_BIG;
constexpr size_t O_M1 = O_BIG;
constexpr size_t O_U = O_M1;
constexpr size_t O_VT = O_U + (size_t)T * 512 * 2;
constexpr size_t O_QB = O_VT + (size_t)T * 512 * 2;
constexpr size_t O_KB = O_QB + (size_t)T * 512 * 2;
constexpr size_t O_VTB = O_KB + (size_t)T * 512 * 2;
constexpr size_t O_EV_END = O_VTB + (size_t)T * 512 * 2;
constexpr size_t O_CQ = O_M1;
constexpr size_t O_CKV = O_CQ + (size_t)T * 256 * 2;
constexpr size_t O_QC = O_CKV + (size_t)T * 128 * 2;
constexpr size_t O_KC = O_QC + (size_t)T * 8 * 96 * 2;
constexpr size_t O_VTC = O_KC + (size_t)T * 8 * 96 * 2;
constexpr size_t O_QD = O_VTC + (size_t)T * 512 * 2;
constexpr size_t O_KD = O_QD + (size_t)T * 512 * 2;
constexpr size_t O_VTD = O_KD + (size_t)T * 128 * 2;
constexpr size_t O_OD_END = O_VTD + (size_t)T * 128 * 2;
constexpr size_t O_H_END = O_H + (size_t)T * DFF * 2;
static_assert(O_OD_END <= ((size_t)256 << 20) && O_EV_END <= ((size_t)256 << 20) && O_H_END <= ((size_t)256 << 20), "ws map");

struct Params {
  const float* x; const float* ffn1_norm; const float* ffn1_w_gu; const float* ffn1_w_down;
  const float* ffn2_norm; const float* ffn2_w_gu; const float* ffn2_w_down;
  const float* ev_norm; const float* ev_w_in; const float* ev_sgu_norm; const float* ev_w_s; const float* ev_b_s;
  const float* ev_q_norm; const float* ev_k_norm; const float* ev_lam_q1; const float* ev_lam_k1; const float* ev_lam_q2; const float* ev_lam_k2;
  const float* ev_sub_norm; const float* ev_w_out;
  const float* od_norm; const float* od_w_in; const float* od_cq_norm; const float* od_ckv_norm; const float* od_w_uq; const float* od_w_ukv;
  const float* od_mla_q_norm; const float* od_mla_k_norm; const float* od_gqa_q_norm; const float* od_gqa_k_norm; const float* od_w_out;
  float* out; char* ws; int flags; int pad;
};

__device__ __forceinline__ unsigned pk2(float lo, float hi) { f32x2_t v = {lo, hi}; bf16x2_t b = __builtin_convertvector(v, bf16x2_t); return __builtin_bit_cast(unsigned, b); }
__device__ __forceinline__ bf16_t f2bf(float f) { return (bf16_t)(pk2(f, 0.f) & 0xffffu); }
__device__ __forceinline__ float fexp2(float x) { return __builtin_amdgcn_exp2f(x); }
__device__ __forceinline__ float frcp(float x) { return __builtin_amdgcn_rcpf(x); }
__device__ __forceinline__ float sigm(float x) { return frcp(1.f + fexp2(-LOG2E * x)); }
__device__ __forceinline__ float gelu_tanh(float x) { const float y = 0.7978845608028654f * (x + 0.044715f * x * x * x); return x * sigm(2.f * y); }
__device__ __forceinline__ float bf2f(unsigned short b) { return __builtin_bit_cast(float, (unsigned)b << 16); }
__device__ __forceinline__ int swz23(int r) { return (r & ~12) | ((r & 4) << 1) | ((r & 8) >> 1); }
__device__ __forceinline__ float rstd16(const float* __restrict__ ssq, int tok) {
  const f32x4* p = (const f32x4*)(ssq + (size_t)tok * 16);
  const f32x4 a = p[0], b = p[1], c = p[2], d = p[3];
  const float s = ((a[0] + a[1]) + (a[2] + a[3])) + ((b[0] + b[1]) + (b[2] + b[3])) + ((c[0] + c[1]) + (c[2] + c[3])) + ((d[0] + d[1]) + (d[2] + d[3]));
  return rsqrtf(s * (1.f / 1024.f) + EPS);
}
#define MFMA(a, b, c) __builtin_amdgcn_mfma_f32_32x32x16_bf16((a), (b), (c), 0, 0, 0)

namespace pg8 {
#define PG8_LAS __attribute__((address_space(3)))
typedef unsigned short bf16_t;
typedef short bf16x8 __attribute__((ext_vector_type(8)));
typedef float f32x4 __attribute__((ext_vector_type(4)));
typedef unsigned u32x4 __attribute__((ext_vector_type(4)));
constexpr int BM = 256, BK = 64, HALF = 128, HTB = HALF * BK * 2  , STAGE_BYTES = 8 * HTB, NXCD = 8, WGM = 8;

__host__ __device__ __forceinline__ int lds_byte(int r, int c) { const int st = (r >> 4) * 2 + (c >> 5), rr = r & 15, cc = c & 31, ob = rr * 64 + cc * 2; return st * 1024 + (ob ^ (((ob >> 9) & 1) << 5)); }
__host__ __device__ __forceinline__ void stage_rc(int b, int& R, int& C) { const int st = b / 1024, sb = b % 1024, swz = sb ^ (((sb >> 9) & 1) << 5); R = (st >> 1) * 16 + swz / 64; C = (st & 1) * 32 + (swz % 64) / 2; }
__host__ __device__ __forceinline__ int perm32(int rho) { const int n = rho >> 4, i = rho & 15; return 8 * (i >> 2) + 4 * n + (i & 3); }

struct Unit { int pm, pn; };
struct Gemm { const bf16_t* A; const bf16_t* Bt; int M, N, K; };

struct StaticOrder {
    int nM, nN, nwg, G, c;
    __host__ __device__ void init(int M, int N, int G_, int c_) { nM = M / BM; nN = N / BM; nwg = nM * nN; G = G_; c = c_; }
    __host__ __device__ bool next(int i, Unit& u) const {
        const long L = (long)i * G + c; if (L >= nwg) return false;
        int wgid = (int)L; { const int q = nwg / NXCD, r = nwg % NXCD, xcd = wgid % NXCD, off = wgid / NXCD; wgid = (xcd < r ? xcd * (q + 1) : r * (q + 1) + (xcd - r) * q) + off; }
        const int nig = WGM * nN, gid = wgid / nig, fm = gid * WGM, gsz = (nM - fm) < WGM ? (nM - fm) : WGM;
        u.pm = fm + ((wgid % nig) % gsz); u.pn = (wgid % nig) / gsz; return true;
    }
    __device__ __forceinline__ void a_ready(const Unit&) const {}
    __device__ __forceinline__ void done(const Unit&) const {}
};
__device__ __forceinline__ unsigned cvt_pk_bf16(float lo, float hi) { unsigned r; asm volatile("v_cvt_pk_bf16_f32 %0, %1, %2" : "=v"(r) : "v"(lo), "v"(hi)); return r; }
typedef _Float16 f16x8 __attribute__((ext_vector_type(8)));
template <bool F16> __device__ __forceinline__ f32x4 mma16(bf16x8 b, bf16x8 a, f32x4 c) {
    if constexpr (F16) return __builtin_amdgcn_mfma_f32_16x16x32_f16(__builtin_bit_cast(f16x8, b), __builtin_bit_cast(f16x8, a), c, 0, 0, 0);
    else return __builtin_amdgcn_mfma_f32_16x16x32_bf16(b, a, c, 0, 0, 0);
}
template <class Epi, class Sched, bool ALIGN_EPI = false, bool SP2 = false, bool F16 = false, bool TOKPERM = false>
__device__ __forceinline__ void gemm_phase(PG8_LAS unsigned char* lds, const Gemm g, const Sched& S, const Epi& E) {
    int tid_ = threadIdx.x; asm volatile("" : "+v"(tid_));
    const int tid = tid_, wid = __builtin_amdgcn_readfirstlane(tid >> 6), lane = tid & 63, wr = wid >> 2, wc = wid & 3, fr = lane & 15, fq = lane >> 4;
    const int K = g.K, nt = K / BK;
    unsigned voffA[2], voffB[2];
#pragma unroll
    for (int i = 0; i < 2; ++i) { int R, C; stage_rc(tid * 16 + i * 8192, R, C); const int Rb = Epi::PERM ? ((R & ~31) + perm32(R & 31)) : R;
        const int Ra = TOKPERM ? ((R & ~63) + 4 * (R & 15) + ((R >> 4) & 3)) : R;
        voffA[i] = (unsigned)(Ra * K + C) * 2u; voffB[i] = (unsigned)(Rb * K + C) * 2u; }
    const size_t kstep = (size_t)(BK * 2);
    const size_t hstep = (size_t)HALF * K * 2;
    const size_t tstep = 2 * hstep;
    const unsigned ldsw = (unsigned)wid * 1024u;
    const int aoff = lds_byte(wr * 64 + fr, fq * 8), boff = lds_byte(wc * 32 + fr, fq * 8);
#define PG8_SA(b, h) (((b) * 2 + (h)) * HTB)
#define PG8_SB(b, h) ((4 + (b) * 2 + (h)) * HTB)
#define PG8_STAGE(bufoff, gbase, voff) do { _Pragma("unroll") for (int _i = 0; _i < 2; ++_i) \
        __builtin_amdgcn_global_load_lds((const unsigned*)((const char*)(gbase) + (voff)[_i]), (PG8_LAS unsigned*)(lds + (bufoff) + ldsw + _i * 8192), 16, 0, 0); } while (0)
#define PG8_LDA(dst, b, h) do { _Pragma("unroll") for (int m = 0; m < 4; ++m) _Pragma("unroll") for (int k = 0; k < 2; ++k) dst[m][k] = *(const PG8_LAS bf16x8*)(lds + PG8_SA(b, h) + aoff + m * 2048 + k * 1024); } while (0)
#define PG8_LDB(dst, b, h) do { _Pragma("unroll") for (int n = 0; n < 2; ++n) _Pragma("unroll") for (int k = 0; k < 2; ++k) dst[n][k] = *(const PG8_LAS bf16x8*)(lds + PG8_SB(b, h) + boff + n * 2048 + k * 1024); } while (0)
#define PG8_MMA(ai, bj, At, Bt) do { __builtin_amdgcn_s_setprio(1); _Pragma("unroll") for (int m = 0; m < 4; ++m) _Pragma("unroll") for (int n = 0; n < 2; ++n) _Pragma("unroll") for (int k = 0; k < 2; ++k) \
        acc[ai][bj][m][n] = mma16<F16>(Bt[n][k], At[m][k], acc[ai][bj][m][n]); __builtin_amdgcn_s_setprio(0); } while (0)
#define PG8_WAIT_V(n) asm volatile("s_waitcnt vmcnt(" #n ")" ::: "memory")
#define PG8_WAIT_L(n) asm volatile("s_waitcnt lgkmcnt(" #n ")" ::: "memory")
#define PG8_BAR __builtin_amdgcn_s_barrier()
#define PG8_SCHED __builtin_amdgcn_sched_barrier(0)
    Unit cur, nxt; int ui = 0;
    if (!S.next(0, cur)) return;
    f32x4 acc[2][2][4][2];
#pragma unroll
    for (int a = 0; a < 2; ++a)
#pragma unroll
        for (int b = 0; b < 2; ++b)
#pragma unroll
            for (int m = 0; m < 4; ++m)
#pragma unroll
                for (int n = 0; n < 2; ++n) acc[a][b][m][n] = (f32x4){0.f, 0.f, 0.f, 0.f};
    bf16x8 At[4][2], B0[2][2], B1[2][2];
    const char* cA = (const char*)g.A + (size_t)cur.pm * tstep; const char* cB = (const char*)g.Bt + (size_t)cur.pn * tstep;
    S.a_ready(cur);
    if constexpr (SP2) {
        PG8_STAGE(PG8_SB(0, 0), cB, voffB); PG8_STAGE(PG8_SB(0, 1), cB + hstep, voffB); PG8_STAGE(PG8_SA(0, 0), cA, voffA); PG8_STAGE(PG8_SA(0, 1), cA + hstep, voffA);
        if (wr == 1) PG8_BAR;
        PG8_WAIT_V(2); PG8_BAR;
        PG8_STAGE(PG8_SB(1, 0), cB + kstep, voffB); PG8_STAGE(PG8_SA(1, 0), cA + kstep, voffA); PG8_STAGE(PG8_SB(1, 1), cB + hstep + kstep, voffB);
        PG8_WAIT_V(6); PG8_BAR;
    } else {
        PG8_STAGE(PG8_SB(0, 0), cB, voffB); PG8_STAGE(PG8_SA(0, 0), cA, voffA); PG8_STAGE(PG8_SB(0, 1), cB + hstep, voffB); PG8_STAGE(PG8_SA(0, 1), cA + hstep, voffA);
        if (wr == 1) PG8_BAR;
        PG8_WAIT_V(4); PG8_BAR;
        PG8_STAGE(PG8_SB(1, 0), cB + kstep, voffB); PG8_STAGE(PG8_SA(1, 0), cA + kstep, voffA); PG8_STAGE(PG8_SB(1, 1), cB + hstep + kstep, voffB);
        PG8_WAIT_V(6); PG8_BAR;
    }
    for (;;) {
        const bool has_next = S.next(ui + 1, nxt);
        const char* nA = has_next ? (const char*)g.A + (size_t)nxt.pm * tstep : cA; const char* nB = has_next ? (const char*)g.Bt + (size_t)nxt.pn * tstep : cB;
        for (int t = 0; t < nt; t += 2) {
            const bool last = (t == nt - 2);
            const char* a1 = cA + (size_t)(t + 1) * kstep;
            const char* a2 = last ? nA : cA + (size_t)(t + 2) * kstep; const char* b2 = last ? nB : cB + (size_t)(t + 2) * kstep;
            const char* a3 = a2 + kstep; const char* b3 = b2 + kstep;
            if (last && has_next) S.a_ready(nxt);
            if constexpr (SP2) {
            PG8_LDB(B0, 0, 0); PG8_LDB(B1, 0, 1); PG8_SCHED; PG8_LDA(At, 0, 0); PG8_STAGE(PG8_SA(1, 1), a1 + hstep, voffA);
            PG8_WAIT_V(8); PG8_WAIT_L(0); PG8_BAR; PG8_MMA(0, 0, At, B0); PG8_MMA(0, 1, At, B1); PG8_BAR; PG8_SCHED;
            PG8_LDA(At, 0, 1); PG8_STAGE(PG8_SB(0, 0), b2, voffB); PG8_STAGE(PG8_SB(0, 1), b2 + hstep, voffB); PG8_STAGE(PG8_SA(0, 0), a2, voffA);
            PG8_WAIT_V(8); PG8_WAIT_L(0); PG8_BAR; PG8_MMA(1, 0, At, B0); PG8_MMA(1, 1, At, B1); PG8_BAR; PG8_SCHED;
            PG8_LDB(B0, 1, 0); PG8_LDB(B1, 1, 1); PG8_SCHED; PG8_LDA(At, 1, 0); PG8_STAGE(PG8_SA(0, 1), a2 + hstep, voffA);
            PG8_WAIT_V(8); PG8_WAIT_L(0); PG8_BAR; PG8_MMA(0, 0, At, B0); PG8_MMA(0, 1, At, B1); PG8_BAR; PG8_SCHED;
            PG8_LDA(At, 1, 1); PG8_STAGE(PG8_SB(1, 0), b3, voffB); PG8_STAGE(PG8_SB(1, 1), b3 + hstep, voffB); PG8_STAGE(PG8_SA(1, 0), a3, voffA);
            PG8_WAIT_V(8); PG8_WAIT_L(0); PG8_BAR; PG8_MMA(1, 0, At, B0); PG8_MMA(1, 1, At, B1); PG8_BAR; PG8_SCHED;
            } else {
            PG8_LDB(B0, 0, 0); PG8_SCHED; PG8_LDA(At, 0, 0); PG8_STAGE(PG8_SA(1, 1), a1 + hstep, voffA);
            PG8_WAIT_L(8); PG8_BAR; PG8_WAIT_L(0); PG8_MMA(0, 0, At, B0); PG8_BAR; PG8_SCHED;
            PG8_LDB(B1, 0, 1); PG8_STAGE(PG8_SB(0, 0), b2, voffB);
            PG8_BAR; PG8_WAIT_L(0); PG8_MMA(0, 1, At, B1); PG8_BAR;
            PG8_LDA(At, 0, 1); PG8_STAGE(PG8_SA(0, 0), a2, voffA);
            PG8_BAR; PG8_WAIT_L(0); PG8_MMA(1, 0, At, B0); PG8_BAR; PG8_SCHED;
            PG8_STAGE(PG8_SB(0, 1), b2 + hstep, voffB);
            PG8_WAIT_V(6); PG8_BAR; PG8_MMA(1, 1, At, B1); PG8_BAR;
            PG8_LDB(B0, 1, 0); PG8_SCHED; PG8_LDA(At, 1, 0); PG8_STAGE(PG8_SA(0, 1), a2 + hstep, voffA);
            PG8_WAIT_L(8); PG8_BAR; PG8_WAIT_L(0); PG8_MMA(0, 0, At, B0); PG8_BAR; PG8_SCHED;
            PG8_LDB(B1, 1, 1); PG8_STAGE(PG8_SB(1, 0), b3, voffB);
            PG8_BAR; PG8_WAIT_L(0); PG8_MMA(0, 1, At, B1); PG8_BAR;
            PG8_LDA(At, 1, 1); PG8_STAGE(PG8_SA(1, 0), a3, voffA);
            PG8_BAR; PG8_WAIT_L(0); PG8_MMA(1, 0, At, B0); PG8_BAR; PG8_SCHED;
            PG8_STAGE(PG8_SB(1, 1), b3 + hstep, voffB);
            PG8_WAIT_V(6); PG8_BAR; PG8_MMA(1, 1, At, B1); PG8_BAR;
            }
        }
        if constexpr (ALIGN_EPI) { if (wr == 0) PG8_BAR; }
        if constexpr (!Epi::AFTER_DRAIN) { E(acc, cur, wr, wc, fr, fq); S.done(cur); }
        if (!has_next) break;
#pragma unroll
        for (int a = 0; a < 2; ++a)
#pragma unroll
            for (int b = 0; b < 2; ++b)
#pragma unroll
                for (int m = 0; m < 4; ++m)
#pragma unroll
                    for (int n = 0; n < 2; ++n) acc[a][b][m][n] = (f32x4){0.f, 0.f, 0.f, 0.f};
        cur = nxt; cA = nA; cB = nB; ++ui;
        if constexpr (ALIGN_EPI) { if (wr == 1) PG8_BAR; }
    }
    PG8_WAIT_V(0);
    if constexpr (!ALIGN_EPI) { if (wr == 0) PG8_BAR; }
    PG8_BAR;
    if constexpr (Epi::AFTER_DRAIN) { E.fused(acc, cur, wr, wc, fr, fq, lds, wid, lane); S.done(cur); }
#undef PG8_SA
#undef PG8_SB
#undef PG8_STAGE
#undef PG8_LDA
#undef PG8_LDB
#undef PG8_MMA
#undef PG8_WAIT_V
#undef PG8_WAIT_L
#undef PG8_BAR
#undef PG8_SCHED
}
}

struct EpiGU8 {
  static constexpr bool PERM = true, AFTER_DRAIN = false;
  const float* ssq; bf16_t* hbuf;
  __device__ __forceinline__ void operator()(const pg8::f32x4 (&acc)[2][2][4][2], const pg8::Unit& u, int wr, int wc, int fr, int fq) const {
    int z; asm volatile("v_mov_b32 %0, 0" : "=v"(z));
    const int row0 = u.pm * 256 + wr * 64 + fr + z, col0 = u.pn * 128 + wc * 32 + 8 * fq + z;
#pragma unroll
    for (int ai = 0; ai < 2; ++ai) {
      float rs[4];
#pragma unroll
      for (int m = 0; m < 4; ++m) { const f32x4 a = *(const f32x4*)(ssq + (unsigned)(row0 + ai * 128 + m * 16) * 16 + 4 * fq); rs[m] = (a[0] + a[1]) + (a[2] + a[3]); }
#pragma unroll
      for (int m = 0; m < 4; ++m) { float v = rs[m]; v += __shfl_xor(v, 16); v += __shfl_xor(v, 32); rs[m] = rsqrtf(v * (1.f / 1024.f) + EPS); }
#pragma unroll
      for (int m = 0; m < 4; ++m) {
        const float r = rs[m]; float v[8];
#pragma unroll
        for (int n = 0; n < 2; ++n)
#pragma unroll
          for (int c = 0; c < 4; ++c) { const float g = acc[ai][0][m][n][c] * r, uu = acc[ai][1][m][n][c] * r; v[4 * n + c] = g * sigm(g) * uu; }
        u32x4 w; w.x = pk2(v[0], v[1]); w.y = pk2(v[2], v[3]); w.z = pk2(v[4], v[5]); w.w = pk2(v[6], v[7]);
        *(u32x4*)(hbuf + (unsigned)(row0 + ai * 128 + m * 16) * DFF + col0) = w;
      }
      asm volatile("" ::: "memory");
    }
  }
};
struct EpiRes8 {
  static constexpr bool PERM = true, AFTER_DRAIN = false;
  typedef _Float16 h8_t __attribute__((ext_vector_type(8))); typedef float f8_t __attribute__((ext_vector_type(8)));
  _Float16* x16; float* xout; bf16_t* xb; float* ssq; float sc; int aux;
  __device__ __forceinline__ void operator()(const pg8::f32x4 (&acc)[2][2][4][2], const pg8::Unit& u, int wr, int wc, int fr, int fq) const {
    int z; asm volatile("v_mov_b32 %0, 0" : "=v"(z));
    const int row0 = u.pm * 256 + wr * 64 + fr + z, colb = u.pn * 256 + wc * 32 + 8 * fq + z;
#pragma unroll
    for (int ai = 0; ai < 2; ++ai)
#pragma unroll
      for (int m = 0; m < 4; ++m) {
        const int tok = row0 + ai * 128 + m * 16; float ss = 0.f;
#pragma unroll
        for (int bj = 0; bj < 2; ++bj) {
          const unsigned off = (unsigned)tok * DM + colb + 128 * bj;
          f8_t n = __builtin_convertvector(*(const h8_t*)(x16 + off), f8_t);
#pragma unroll
          for (int c = 0; c < 4; ++c) { n[c] += sc * acc[ai][bj][m][0][c]; n[4 + c] += sc * acc[ai][bj][m][1][c]; }
          if (aux) {
            *(h8_t*)(x16 + off) = __builtin_convertvector(n, h8_t);
            ss += ((n[0] * n[0] + n[1] * n[1]) + (n[2] * n[2] + n[3] * n[3])) + ((n[4] * n[4] + n[5] * n[5]) + (n[6] * n[6] + n[7] * n[7]));
          } else {
            *(f32x4*)(xout + off) = (f32x4){n[0], n[1], n[2], n[3]}; *(f32x4*)(xout + off + 4) = (f32x4){n[4], n[5], n[6], n[7]};
          }
        }
        if (aux) { ss += __shfl_xor(ss, 16); ss += __shfl_xor(ss, 32); if (fq == 0) ssq[(unsigned)tok * 16 + u.pn * 4 + wc] = ss; }
        if (m & 1) asm volatile("" ::: "memory");
      }
  }
};

template <bool FULL, int MODE, class Epi>
__device__ __forceinline__ void gemm_phase(const bf16_t* __restrict__ P, int ldp, int NP, const bf16_t* __restrict__ Q, int ldq, int K, char* smem, const Epi& epi) {
  constexpr int PITCH = 144, OPB = 256 * PITCH;
  const int G = gridDim.x, bid = blockIdx.x;
  const int PP = (NP % 4 == 0) ? 4 : ((NP % 2 == 0) ? 2 : 1);
  const int L = G >> 3;
  const bool patch = (G & 7) == 0 && (L % PP) == 0 && (64 % (L / PP)) == 0;
  const int xcd = bid & 7, loc = bid >> 3, PQ = patch ? L / PP : 1, npp = NP / PP, npatch = patch ? npp * (64 / PQ) : 0;
  const int niter = (MODE == 1) ? (256 + G - 1) / G : (patch ? (npatch + 7) / 8 : (NP * 64 + G - 1) / G);
  auto coords = [&](int it, int& p0, int& q0) -> bool {
    if (MODE == 1) { const int t = bid + it * G; p0 = (t >> 5) * 128; q0 = t * 256; return t < 256; }
    if (patch) { const int pidx = xcd + 8 * it; p0 = ((pidx % npp) * PP + loc % PP) * 256; q0 = ((pidx / npp) * PQ + loc / PP) * 256; return pidx < npatch; }
    const int t = bid + it * G; p0 = (t % NP) * 256; q0 = (t / NP) * 256; return t < NP * 64;
  };
  int tid = threadIdx.x; asm volatile("" : "+v"(tid));
  const int lane = tid & 63, wid = tid >> 6;
  const int wp = wid >> 2, wq = wid & 3;
  const int r = lane & 31, h = lane >> 5;
  const int lr = tid >> 3, lc = tid & 7;
  const int nk = K >> 6;
  const int rot = (int)((unsigned)loc % (unsigned)nk);
  char* sP = smem; char* sQ = smem + 2 * OPB;
  const int wofs = lr * PITCH + lc * 16;
  const int aofs = (wp * 128 + r) * PITCH + h * 16;
  const int bofs = (wq * 64 + r) * PITCH + h * 16;
  int it = 0, p0 = 0, q0 = 0;
  if (niter <= 0 || !coords(0, p0, q0)) return;
  const bf16_t* gp = P + (size_t)(p0 + lr) * ldp + lc * 8;
  const bf16_t* gq = Q + (size_t)(q0 + lr) * ldq + lc * 8;
  u32x4 rp[4], rq[4];
#pragma unroll
  for (int j = 0; j < 4; ++j) { rp[j] = *(const u32x4*)(gp + (size_t)(64 * j) * ldp + rot * 64); rq[j] = *(const u32x4*)(gq + (size_t)(64 * j) * ldq + rot * 64); }
#pragma unroll 1
  for (;;) {
    float pre[2];
    epi.prefetch(pre, q0 + wq * 64, lane);
    f32x16 acc[4][2];
#pragma unroll
    for (int a = 0; a < 4; ++a)
#pragma unroll
      for (int b = 0; b < 2; ++b)
#pragma unroll
        for (int i = 0; i < 16; ++i) acc[a][b][i] = 0.f;
    __syncthreads();
#pragma unroll
    for (int j = 0; j < 4; ++j) { *(u32x4*)(sP + wofs + j * 64 * PITCH) = rp[j]; *(u32x4*)(sQ + wofs + j * 64 * PITCH) = rq[j]; }
    {
      int kk = 1 + rot; if (kk >= nk) kk -= nk;
      const int ko = kk * 64;
#pragma unroll
      for (int j = 0; j < 4; ++j) { rp[j] = *(const u32x4*)(gp + (size_t)(64 * j) * ldp + ko); rq[j] = *(const u32x4*)(gq + (size_t)(64 * j) * ldq + ko); }
    }
#pragma unroll 1
    for (int kt = 0; kt < nk; ++kt) {
      const int cur = kt & 1;
      __syncthreads();
      if (kt + 1 < nk) {
        char* dP = sP + (cur ^ 1) * OPB + wofs; char* dQ = sQ + (cur ^ 1) * OPB + wofs;
#pragma unroll
        for (int j = 0; j < 4; ++j) { *(u32x4*)(dP + j * 64 * PITCH) = rp[j]; *(u32x4*)(dQ + j * 64 * PITCH) = rq[j]; }
        if (kt + 2 < nk) {
          int kk = kt + 2 + rot; if (kk >= nk) kk -= nk;
          const int ko = kk * 64;
#pragma unroll
          for (int j = 0; j < 4; ++j) { rp[j] = *(const u32x4*)(gp + (size_t)(64 * j) * ldp + ko); rq[j] = *(const u32x4*)(gq + (size_t)(64 * j) * ldq + ko); }
        }
      }
      const char* ab = sP + cur * OPB + aofs; const char* bb = sQ + cur * OPB + bofs;
#pragma unroll
      for (int ks = 0; ks < 4; ++ks) {
        bf16x8 a[4], b[2];
#pragma unroll
        for (int pi = 0; pi < 4; ++pi) a[pi] = *(const bf16x8*)(ab + pi * 32 * PITCH + ks * 32);
#pragma unroll
        for (int qi = 0; qi < 2; ++qi) b[qi] = *(const bf16x8*)(bb + qi * 32 * PITCH + ks * 32);
#pragma unroll
        for (int pi = 0; pi < 4; ++pi)
#pragma unroll
          for (int qi = 0; qi < 2; ++qi) acc[pi][qi] = MFMA(a[pi], b[qi], acc[pi][qi]);
      }
    }
    int np0 = 0, nq0 = 0;
    const bool has_next = (it + 1 < niter) && coords(it + 1, np0, nq0);
    if (Epi::XPF && has_next) {
      gp = P + (size_t)(np0 + lr) * ldp + lc * 8; gq = Q + (size_t)(nq0 + lr) * ldq + lc * 8;
#pragma unroll
      for (int j = 0; j < 4; ++j) { rp[j] = *(const u32x4*)(gp + (size_t)(64 * j) * ldp + rot * 64); rq[j] = *(const u32x4*)(gq + (size_t)(64 * j) * ldq + rot * 64); }
    }
    if constexpr (Epi::LDS_OUT) {
      __syncthreads();
      epi.to_lds(*(f32x16 (*)[2][2])(&acc[0]), smem, wp * 64, wq * 64, lane, pre);
      epi.to_lds(*(f32x16 (*)[2][2])(&acc[2]), smem, wp * 64 + 32, wq * 64, lane, pre);
      __syncthreads();
      {
        bf16_t* ob = epi.out_base() + (size_t)q0 * Epi::OUT_LD + (p0 >> 1);
        const int orow = tid >> 4, och = tid & 15;
#pragma unroll
        for (int ps = 0; ps < 8; ++ps) {
          const int row = ps * 32 + orow;
          const u32x4 v = *(const u32x4*)(smem + row * 264 + och * 16);
          *(u32x4*)(ob + (size_t)row * Epi::OUT_LD + och * 8) = v;
        }
      }
    } else if constexpr (FULL) {
      epi(acc, p0 + wp * 128, q0 + wq * 64, lane, pre);
    } else {
      epi(*(f32x16 (*)[2][2])(&acc[0]), p0 + wp * 128, q0 + wq * 64, lane, pre);
      epi(*(f32x16 (*)[2][2])(&acc[2]), p0 + wp * 128 + 64, q0 + wq * 64, lane, pre);
    }
    if (!has_next) break;
    ++it; p0 = np0; q0 = nq0;
    if (!Epi::XPF) {
      gp = P + (size_t)(p0 + lr) * ldp + lc * 8; gq = Q + (size_t)(q0 + lr) * ldq + lc * 8;
#pragma unroll
      for (int j = 0; j < 4; ++j) { rp[j] = *(const u32x4*)(gp + (size_t)(64 * j) * ldp + rot * 64); rq[j] = *(const u32x4*)(gq + (size_t)(64 * j) * ldq + rot * 64); }
    }
  }
}


__device__ __forceinline__ void wave_atomic_max_pos(float v, unsigned* dst) {
#pragma unroll
  for (int o = 32; o >= 1; o >>= 1) v = fmaxf(v, __shfl_xor(v, o));
  if ((threadIdx.x & 63) == 0) atomicMax(dst + (blockIdx.x & 7) * 64, __float_as_uint(v));
}
__device__ __forceinline__ float kmax_of(const unsigned* kmx, int idx) { unsigned m = 0u;
#pragma unroll
  for (int sl = 0; sl < 8; ++sl) m = max(m, kmx[sl * 64 + idx]);
  return sqrtf(__uint_as_float(m)); }
constexpr size_t O_KMAX = 14336;

struct EpiGU {
  static constexpr bool LDS_OUT = true;
  static constexpr bool XPF = true;
  const float* ssq; bf16_t* hbuf;
  static constexpr int OUT_LD = DFF;
  __device__ __forceinline__ bf16_t* out_base() const { return hbuf; }
  __device__ __forceinline__ void to_lds(f32x16 (&acc)[2][2], char* smem, int hl0, int tl0, int lane, const float (&pre)[2]) const {
    const int r = lane & 31, h = lane >> 5;
#pragma unroll
    for (int qi = 0; qi < 2; ++qi) {
      const float rs = pre[qi];
      char* dst = smem + (tl0 + 32 * qi + r) * 264 + (hl0 + 4 * h) * 2;
#pragma unroll
      for (int i4 = 0; i4 < 4; ++i4) {
        float v[4];
#pragma unroll
        for (int c = 0; c < 4; ++c) { const float g = acc[0][qi][4 * i4 + c] * rs, u = acc[1][qi][4 * i4 + c] * rs; v[c] = g * sigm(g) * u; }
        u32x2 w; w.x = pk2(v[0], v[1]); w.y = pk2(v[2], v[3]);
        *(u32x2*)(dst + 16 * i4) = w;
      }
    }
  }
  __device__ __forceinline__ void prefetch(float (&pre)[2], int tbase, int lane) const { const int r = lane & 31;
#pragma unroll
    for (int qi = 0; qi < 2; ++qi) pre[qi] = rstd16(ssq, tbase + 32 * qi + r); }
  __device__ __forceinline__ void operator()(f32x16 (&acc)[2][2], int fbase, int tbase, int lane, const float (&pre)[2]) const {
    const int r = lane & 31, h = lane >> 5, j0 = fbase >> 1;
#pragma unroll
    for (int qi = 0; qi < 2; ++qi) {
      const int tok = tbase + 32 * qi + r; const float rs = pre[qi];
      bf16_t* hp = hbuf + (unsigned)tok * DFF + j0 + 4 * h;
#pragma unroll
      for (int i4 = 0; i4 < 4; ++i4) {
        float v[4];
#pragma unroll
        for (int c = 0; c < 4; ++c) { const float g = acc[0][qi][4 * i4 + c] * rs, u = acc[1][qi][4 * i4 + c] * rs; v[c] = g * sigm(g) * u; }
        u32x2 w; w.x = pk2(v[0], v[1]); w.y = pk2(v[2], v[3]);
        *(u32x2*)(hp + 8 * i4) = w;
      }
    }
  }
};

struct EpiResid {
  static constexpr bool LDS_OUT = false;
  static constexpr bool XPF = true;
  const float* xold; float* xnew; bf16_t* xb; float* ssq; float sc; int aux;
  __device__ __forceinline__ void prefetch(float (&pre)[2], int tbase, int lane) const { pre[0] = 0.f; pre[1] = 0.f; }
  __device__ __forceinline__ void operator()(f32x16 (&acc)[2][2], int fbase, int tbase, int lane, const float (&pre)[2]) const {
    const int r = lane & 31, h = lane >> 5;
#pragma unroll
    for (int qi = 0; qi < 2; ++qi) {
      const int tok = tbase + 32 * qi + r; float ss = 0.f;
#pragma unroll
      for (int pi = 0; pi < 2; ++pi)
#pragma unroll
        for (int i4 = 0; i4 < 4; ++i4) {
          const size_t off = (unsigned)tok * DM + fbase + 32 * pi + 8 * i4 + 4 * h;
          const f32x4 xo = *(const f32x4*)(xold + off); f32x4 xn;
#pragma unroll
          for (int c = 0; c < 4; ++c) xn[c] = xo[c] + sc * acc[pi][qi][4 * i4 + c];
          *(f32x4*)(xnew + off) = xn;
          if (aux) { u32x2 w; w.x = pk2(xn[0], xn[1]); w.y = pk2(xn[2], xn[3]); *(u32x2*)(xb + off) = w; ss += (xn[0] * xn[0] + xn[1] * xn[1]) + (xn[2] * xn[2] + xn[3] * xn[3]); }
        }
      if (aux) { ss += __shfl_xor(ss, 32); if (h == 0) ssq[(unsigned)tok * 16 + (fbase >> 6)] = ss; }
    }
  }
};

__device__ __forceinline__ float ss64(const float (&v)[2][16]) {
  float s = 0.f;
#pragma unroll
  for (int pi = 0; pi < 2; ++pi)
#pragma unroll
    for (int i = 0; i < 16; ++i) s += v[pi][i] * v[pi][i];
  return s + __shfl_xor(s, 32);
}
__device__ __forceinline__ void store_tok64_bf16(bf16_t* dst  , const float (&v)[2][16], int h) {
#pragma unroll
  for (int pi = 0; pi < 2; ++pi)
#pragma unroll
    for (int i4 = 0; i4 < 4; ++i4) { u32x2 w; w.x = pk2(v[pi][4 * i4], v[pi][4 * i4 + 1]); w.y = pk2(v[pi][4 * i4 + 2], v[pi][4 * i4 + 3]); *(u32x2*)(dst + 32 * pi + 8 * i4 + 4 * h) = w; }
}
__device__ __forceinline__ void store_feat_major(bf16_t* dst, unsigned pitch, const float (&v)[2][16], int h) {
#pragma unroll
  for (int pi = 0; pi < 2; ++pi)
#pragma unroll
    for (int i = 0; i < 16; ++i) dst[(unsigned)(32 * pi + 8 * (i >> 2) + 4 * h + (i & 3)) * pitch] = f2bf(v[pi][i]);
}

struct EpiEvIn {
  static constexpr bool LDS_OUT = false;
  static constexpr bool XPF = true;
  const float* ssq; const float* sgu_norm; const float* q_norm; const float* k_norm; const float* cos64; const float* sin64;
  bf16_t* ub; bf16_t* vt; bf16_t* qb; bf16_t* kb; bf16_t* vtb; unsigned* kmax2;
  __device__ __forceinline__ void prefetch(float (&pre)[2], int tbase, int lane) const { const int r = lane & 31;
#pragma unroll
    for (int qi = 0; qi < 2; ++qi) pre[qi] = rstd16(ssq, tbase + 32 * qi + r); }
  __device__ __forceinline__ void operator()(f32x16 (&acc)[2][2], int fbase, int tbase, int lane, const float (&pre)[2]) const {
    const int r = lane & 31, h = lane >> 5, gidx = fbase >> 6;
#pragma unroll
    for (int qi = 0; qi < 2; ++qi) {
      const int tok = tbase + 32 * qi + r; const float rs = pre[qi];
      const int bb = tok >> 13, pos = tok & (S - 1);
      float v[2][16];
#pragma unroll
      for (int pi = 0; pi < 2; ++pi)
#pragma unroll
        for (int i = 0; i < 16; ++i) v[pi][i] = acc[pi][qi][i] * rs;
      if (gidx < 8) {
#pragma unroll
        for (int pi = 0; pi < 2; ++pi)
#pragma unroll
          for (int i = 0; i < 16; ++i) v[pi][i] = gelu_tanh(v[pi][i]);
        store_tok64_bf16(ub + (unsigned)tok * 512 + gidx * 64, v, h);
      } else if (gidx < 16) {
        const int g = gidx - 8;
#pragma unroll
        for (int pi = 0; pi < 2; ++pi)
#pragma unroll
          for (int i = 0; i < 16; ++i) v[pi][i] = gelu_tanh(v[pi][i]);
        const float rn = rsqrtf(ss64(v) * (1.f / 64.f) + EPS);
#pragma unroll
        for (int pi = 0; pi < 2; ++pi)
#pragma unroll
          for (int i = 0; i < 16; ++i) v[pi][i] *= rn * sgu_norm[g * 64 + 32 * pi + 8 * (i >> 2) + 4 * h + (i & 3)];
        store_feat_major(vt + ((unsigned)(g * 128 + (tok >> 7)) * 64) * 128 + (tok & 127), 128, v, h);
      } else if (gidx < 32) {
        const bool isq = gidx < 24; const int hm = isq ? gidx - 16 : gidx - 24;
        const float* gn = isq ? q_norm : k_norm;
        const float rn = rsqrtf(ss64(v) * (1.f / 64.f) + EPS) * (isq ? 0.125f * LOG2E : 1.f);
#pragma unroll
        for (int i = 0; i < 16; ++i) {
          const int d = 8 * (i >> 2) + 4 * h + (i & 3);
          const float x1 = v[0][i] * rn * gn[d], x2 = v[1][i] * rn * gn[d + 32];
          const float c = cos64[pos * 32 + d], s = sin64[pos * 32 + d];
          v[0][i] = x1 * c - x2 * s; v[1][i] = x1 * s + x2 * c;
        }
        store_tok64_bf16((isq ? qb : kb) + ((unsigned)(bb * 8 + hm) * S + pos) * 64, v, h);
        if (!isq) wave_atomic_max_pos(ss64(v), kmax2 + bb * 8 + hm);
      } else {
        const int hv = (gidx - 32) >> 1, eh = (gidx - 32) & 1;
        store_feat_major(vtb + ((unsigned)(bb * 4 + hv) * 128 + 64 * eh) * S + pos, S, v, h);
      }
    }
  }
};

__device__ __forceinline__ void rope32(float (&v)[16], const float* __restrict__ cos32, const float* __restrict__ sin32, int p, int h) {
#pragma unroll
  for (int i = 0; i < 8; ++i) {
    const int d = 8 * (i >> 2) + 4 * h + (i & 3);
    const float c = cos32[p * 16 + d], s = sin32[p * 16 + d];
    const float x1 = v[i], x2 = v[i + 8];
    v[i] = x1 * c - x2 * s; v[i + 8] = x1 * s + x2 * c;
  }
}

struct EpiOdIn {
  static constexpr bool LDS_OUT = false;
  static constexpr bool XPF = true;
  const float* ssq; const float* gq_norm; const float* gk_norm; const float* cos32; const float* sin32;
  bf16_t* cq; bf16_t* ckv; float* ssq2; float* kpe; bf16_t* qd; bf16_t* kd; bf16_t* vtd; unsigned* kmax2;
  __device__ __forceinline__ void prefetch(float (&pre)[2], int tbase, int lane) const { const int r = lane & 31;
#pragma unroll
    for (int qi = 0; qi < 2; ++qi) pre[qi] = rstd16(ssq, tbase + 32 * qi + r); }
  __device__ __forceinline__ void operator()(f32x16 (&acc)[2][2], int fbase, int tbase, int lane, const float (&pre)[2]) const {
    const int r = lane & 31, h = lane >> 5, gidx = fbase >> 6;
    if (gidx >= 19) return;
#pragma unroll
    for (int qi = 0; qi < 2; ++qi) {
      const int tok = tbase + 32 * qi + r; const float rs = pre[qi];
      const int bb = tok >> 13, pos = tok & (S - 1);
      float v[2][16];
#pragma unroll
      for (int pi = 0; pi < 2; ++pi)
#pragma unroll
        for (int i = 0; i < 16; ++i) v[pi][i] = acc[pi][qi][i] * rs;
      if (gidx < 6) {
        const float ss = ss64(v);
        if (h == 0) ssq2[(unsigned)tok * 8 + gidx] = ss;
        if (gidx < 4) store_tok64_bf16(cq + (unsigned)tok * 256 + gidx * 64, v, h);
        else store_tok64_bf16(ckv + (unsigned)tok * 128 + (gidx - 4) * 64, v, h);
      } else if (gidx == 6) {
#pragma unroll
        for (int i4 = 0; i4 < 4; ++i4) { f32x4 w = {v[0][4 * i4], v[0][4 * i4 + 1], v[0][4 * i4 + 2], v[0][4 * i4 + 3]}; *(f32x4*)(kpe + (unsigned)tok * 32 + 8 * i4 + 4 * h) = w; }
      } else if (gidx < 17) {
        const bool isq = gidx < 15; const float* gn = isq ? gq_norm : gk_norm;
        const float rn = rsqrtf(ss64(v) * (1.f / 64.f) + EPS) * (isq ? 0.125f * LOG2E : 1.f);
#pragma unroll
        for (int pi = 0; pi < 2; ++pi)
#pragma unroll
          for (int i = 0; i < 16; ++i) v[pi][i] *= rn * gn[32 * pi + 8 * (i >> 2) + 4 * h + (i & 3)];
        rope32(v[0], cos32, sin32, pos >> 6, h);
        rope32(v[1], cos32, sin32, pos & 63, h);
        if (isq) store_tok64_bf16(qd + ((unsigned)(bb * 8 + (gidx - 7)) * S + pos) * 64, v, h);
        else { store_tok64_bf16(kd + ((unsigned)(bb * 2 + (gidx - 15)) * S + pos) * 64, v, h); wave_atomic_max_pos(ss64(v), kmax2 + 32 + bb * 2 + (gidx - 15)); }
      } else {
        store_feat_major(vtd + ((unsigned)(bb * 2 + (gidx - 17)) * 64) * S + pos, S, v, h);
      }
    }
  }
};

struct EpiUq {
  static constexpr bool LDS_OUT = false;
  static constexpr bool XPF = false;
  const float* ssq2; const float* qn; const float* cos32; const float* sin32; bf16_t* qc;
  __device__ __forceinline__ void prefetch(float (&pre)[2], int tbase, int lane) const { const int r = lane & 31;
#pragma unroll
    for (int qi = 0; qi < 2; ++qi) { const f32x4 sq = *(const f32x4*)(ssq2 + (unsigned)(tbase + 32 * qi + r) * 8); pre[qi] = rsqrtf(((sq[0] + sq[1]) + (sq[2] + sq[3])) * (1.f / 256.f) + EPS); } }
  __device__ __forceinline__ void operator()(f32x16 (&acc)[4][2], int fbase, int tbase, int lane, const float (&pre)[2]) const {
    const int r = lane & 31, h = lane >> 5, head = fbase >> 7;
#pragma unroll
    for (int qi = 0; qi < 2; ++qi) {
    const int tok = tbase + 32 * qi + r, bb = tok >> 13, pos = tok & (S - 1);
    const float rs = pre[qi];
    float v[3][16]; float ss = 0.f;
#pragma unroll
    for (int pi = 0; pi < 3; ++pi)
#pragma unroll
      for (int i = 0; i < 16; ++i) { v[pi][i] = acc[pi][qi][i] * rs; ss += v[pi][i] * v[pi][i]; }
    ss += __shfl_xor(ss, 32);
    const float rn = rsqrtf(ss * (1.f / 96.f) + EPS) * (0.10206207261596575f * LOG2E);
#pragma unroll
    for (int pi = 0; pi < 3; ++pi)
#pragma unroll
      for (int i = 0; i < 16; ++i) v[pi][i] *= rn * qn[32 * pi + 8 * (i >> 2) + 4 * h + (i & 3)];
    rope32(v[2], cos32, sin32, pos, h);
    bf16_t* dst = qc + ((unsigned)(bb * 8 + head) * S + pos) * 96;
#pragma unroll
    for (int pi = 0; pi < 3; ++pi)
#pragma unroll
      for (int i4 = 0; i4 < 4; ++i4) { u32x2 w; w.x = pk2(v[pi][4 * i4], v[pi][4 * i4 + 1]); w.y = pk2(v[pi][4 * i4 + 2], v[pi][4 * i4 + 3]); *(u32x2*)(dst + 32 * pi + 8 * i4 + 4 * h) = w; }
    }
  }
};

struct EpiUkv {
  static constexpr bool LDS_OUT = false;
  static constexpr bool XPF = false;
  const float* ssq2; const float* kn; const float* kpe; const float* cos32; const float* sin32; bf16_t* kc; bf16_t* vtc; unsigned* kmax2;
  __device__ __forceinline__ void prefetch(float (&pre)[2], int tbase, int lane) const { const int r = lane & 31;
#pragma unroll
    for (int qi = 0; qi < 2; ++qi) { const unsigned t8 = (unsigned)(tbase + 32 * qi + r) * 8; pre[qi] = rsqrtf((ssq2[t8 + 4] + ssq2[t8 + 5]) * (1.f / 128.f) + EPS); } }
  __device__ __forceinline__ void operator()(f32x16 (&acc)[2][2], int fbase, int tbase, int lane, const float (&pre)[2]) const {
    int z; asm volatile("v_mov_b32 %0, 0" : "=v"(z));
    const int r = (lane & 31) + z, h = lane >> 5, head = fbase >> 7, isv = (fbase >> 6) & 1;
    float kmx_run = 0.f;
#pragma unroll
    for (int qi = 0; qi < 2; ++qi) {
      const int tok = tbase + 32 * qi + r, bb = tok >> 13, pos = tok & (S - 1);
      const float rs = pre[qi];
      float v[2][16];
#pragma unroll
      for (int pi = 0; pi < 2; ++pi)
#pragma unroll
        for (int i = 0; i < 16; ++i) v[pi][i] = acc[pi][qi][i] * rs;
      if (isv) {
        store_feat_major(vtc + ((unsigned)(bb * 8 + head) * 64) * S + pos, S, v, h);
      } else {
        float pe[16]; float ss = 0.f;
#pragma unroll
        for (int i4 = 0; i4 < 4; ++i4) { const f32x4 w = *(const f32x4*)(kpe + (unsigned)tok * 32 + 8 * i4 + 4 * h);
#pragma unroll
          for (int c = 0; c < 4; ++c) { pe[4 * i4 + c] = w[c]; ss += w[c] * w[c]; } }
#pragma unroll
        for (int pi = 0; pi < 2; ++pi)
#pragma unroll
          for (int i = 0; i < 16; ++i) ss += v[pi][i] * v[pi][i];
        ss += __shfl_xor(ss, 32);
        const float rn = rsqrtf(ss * (1.f / 96.f) + EPS);
#pragma unroll
        for (int pi = 0; pi < 2; ++pi)
#pragma unroll
          for (int i = 0; i < 16; ++i) v[pi][i] *= rn * kn[32 * pi + 8 * (i >> 2) + 4 * h + (i & 3)];
#pragma unroll
        for (int i = 0; i < 16; ++i) pe[i] *= rn * kn[64 + 8 * (i >> 2) + 4 * h + (i & 3)];
        rope32(pe, cos32, sin32, pos, h);
        { float kk = 0.f;
#pragma unroll
          for (int i = 0; i < 16; ++i) kk += pe[i] * pe[i];
          kmx_run = fmaxf(kmx_run, ss64(v) + kk + __shfl_xor(kk, 32)); }
        bf16_t* dst = kc + ((unsigned)(bb * 8 + head) * S + pos) * 96;
        store_tok64_bf16(dst, v, h);
#pragma unroll
        for (int i4 = 0; i4 < 4; ++i4) { u32x2 w; w.x = pk2(pe[4 * i4], pe[4 * i4 + 1]); w.y = pk2(pe[4 * i4 + 2], pe[4 * i4 + 3]); *(u32x2*)(dst + 64 + 8 * i4 + 4 * h) = w; }
      }
    }
    if (!isv) wave_atomic_max_pos(kmx_run, kmax2 + 16 + (tbase >> 13) * 8 + head);
  }
};

struct EpiGmlp {
  static constexpr bool LDS_OUT = false;
  static constexpr bool XPF = false;
  const float* b_s; const bf16_t* ub; bf16_t* mix;
  __device__ __forceinline__ void prefetch(float (&pre)[2], int tbase, int lane) const { pre[0] = 0.f; pre[1] = 0.f; }
  __device__ __forceinline__ void operator()(f32x16 (&acc)[2][2], int fbase, int tbase, int lane, const float (&pre)[2]) const {
    const int r = lane & 31, h = lane >> 5;
    const int g = tbase >> 13, chunk = (tbase & 8191) >> 6;
    fbase -= g * 128;
    if (fbase >= 128) return;
    const float* bs = b_s + g * 128 + fbase + 4 * h;
#pragma unroll
    for (int qi = 0; qi < 2; ++qi) {
      const unsigned tok0 = (unsigned)(chunk * 128 + fbase + 4 * h);
      const unsigned uo = tok0 * 512u + (unsigned)(g * 64 + 32 * qi + r), mo = tok0 * 1024u + (unsigned)(g * 64 + 32 * qi + r);
#pragma unroll
      for (int pi = 0; pi < 2; ++pi)
#pragma unroll
        for (int i = 0; i < 16; ++i) {
          const int io = 32 * pi + 8 * (i >> 2) + (i & 3);
          const float uu = bf2f(ub[uo + (unsigned)(io * 512)]);
          mix[mo + (unsigned)(io * 1024)] = f2bf(uu * (acc[pi][qi][i] + bs[io]));
        }
    }
  }
};


__device__ __forceinline__ float grp_sum(float v) { v += __shfl_xor(v, 16); v += __shfl_xor(v, 32); return v; }
__device__ __forceinline__ float lane32_partner(float a, int lane) {
  auto rr = __builtin_amdgcn_permlane32_swap(__float_as_uint(a), __float_as_uint(a), false, false);
  return __uint_as_float(lane < 32 ? rr[1] : rr[0]);
}
__device__ __forceinline__ void st8_bf16(bf16_t* dst, const float (&v)[8]) { u32x4 w; w.x = pk2(v[0], v[1]); w.y = pk2(v[2], v[3]); w.z = pk2(v[4], v[5]); w.w = pk2(v[6], v[7]); *(u32x4*)dst = w; }

struct EpiEvIn8 {
  static constexpr bool PERM = true, AFTER_DRAIN = false;
  const float* ssq; const float* sgu_norm; const float* q_norm; const float* k_norm; const float* cos64; const float* sin64;
  bf16_t* ub; bf16_t* vt; bf16_t* qb; bf16_t* kb; bf16_t* vtb; unsigned* kmax2;
  __device__ __forceinline__ void operator()(const pg8::f32x4 (&acc)[2][2][4][2], const pg8::Unit& u, int wr, int wc, int fr, int fq) const {
    int z; asm volatile("v_mov_b32 %0, 0" : "=v"(z));
    const int gi = 4 * u.pn + wc;
    const int row0 = u.pm * 256 + wr * 64 + fr + z;
    float kmx_run = 0.f;
#pragma unroll
    for (int ai = 0; ai < 2; ++ai) {
      float rs[4];
#pragma unroll
      for (int m = 0; m < 4; ++m) { const f32x4 a = *(const f32x4*)(ssq + (unsigned)(row0 + ai * 128 + m * 16) * 16 + 4 * fq); rs[m] = (a[0] + a[1]) + (a[2] + a[3]); }
#pragma unroll
      for (int m = 0; m < 4; ++m) rs[m] = rsqrtf(grp_sum(rs[m]) * (1.f / 1024.f) + EPS);
#pragma unroll
      for (int m = 0; m < 4; ++m) {
        const int tok = row0 + ai * 128 + m * 16, bb = tok >> 13, pos = tok & (S - 1);
        float v[2][8];
#pragma unroll
        for (int bj = 0; bj < 2; ++bj)
#pragma unroll
          for (int n = 0; n < 2; ++n)
#pragma unroll
            for (int c = 0; c < 4; ++c) v[bj][4 * n + c] = acc[ai][bj][m][n][c] * rs[m];
        if (gi < 8) {
#pragma unroll
          for (int bj = 0; bj < 2; ++bj) {
#pragma unroll
            for (int e = 0; e < 8; ++e) v[bj][e] = gelu_tanh(v[bj][e]);
            st8_bf16(ub + (unsigned)tok * 512 + gi * 64 + 32 * bj + 8 * fq, v[bj]);
          }
        } else if (gi < 16) {
          const int g = gi - 8; float ss = 0.f;
#pragma unroll
          for (int bj = 0; bj < 2; ++bj)
#pragma unroll
            for (int e = 0; e < 8; ++e) { v[bj][e] = gelu_tanh(v[bj][e]); ss += v[bj][e] * v[bj][e]; }
          const float rn = rsqrtf(grp_sum(ss) * (1.f / 64.f) + EPS);
          bf16_t* dst = vt + ((unsigned)(g * 128 + (tok >> 7)) * 64 + 8 * fq) * 128 + (tok & 127);
#pragma unroll
          for (int bj = 0; bj < 2; ++bj)
#pragma unroll
            for (int e = 0; e < 8; ++e) dst[(32 * bj + e) * 128] = f2bf(v[bj][e] * rn * sgu_norm[g * 64 + 32 * bj + 8 * fq + e]);
        } else if (gi < 32) {
          const bool isq = gi < 24; const int hm = isq ? gi - 16 : gi - 24;
          const float* gn = isq ? q_norm : k_norm;
          float ss = 0.f;
#pragma unroll
          for (int bj = 0; bj < 2; ++bj)
#pragma unroll
            for (int e = 0; e < 8; ++e) ss += v[bj][e] * v[bj][e];
          const float rn = rsqrtf(grp_sum(ss) * (1.f / 64.f) + EPS) * (isq ? 0.125f * LOG2E : 1.f);
          const f32x4 c0 = *(const f32x4*)(cos64 + (unsigned)pos * 32 + 8 * fq), c1 = *(const f32x4*)(cos64 + (unsigned)pos * 32 + 8 * fq + 4);
          const f32x4 s0 = *(const f32x4*)(sin64 + (unsigned)pos * 32 + 8 * fq), s1 = *(const f32x4*)(sin64 + (unsigned)pos * 32 + 8 * fq + 4);
          float kk = 0.f;
#pragma unroll
          for (int e = 0; e < 8; ++e) {
            const float x1 = v[0][e] * rn * gn[8 * fq + e], x2 = v[1][e] * rn * gn[32 + 8 * fq + e];
            const float cc = e < 4 ? c0[e & 3] : c1[e & 3], sn = e < 4 ? s0[e & 3] : s1[e & 3];
            v[0][e] = x1 * cc - x2 * sn; v[1][e] = x1 * sn + x2 * cc;
            kk += v[0][e] * v[0][e] + v[1][e] * v[1][e];
          }
          bf16_t* dst = (isq ? qb : kb) + ((unsigned)(bb * 8 + hm) * S + pos) * 64 + 8 * fq;
          st8_bf16(dst, v[0]); st8_bf16(dst + 32, v[1]);
          if (!isq) kmx_run = fmaxf(kmx_run, grp_sum(kk));
        } else {
          const int hv = (gi - 32) >> 1, eh = (gi - 32) & 1;
          bf16_t* dst = vtb + ((unsigned)(bb * 4 + hv) * 128 + 64 * eh + 8 * fq) * S + pos;
#pragma unroll
          for (int bj = 0; bj < 2; ++bj)
#pragma unroll
            for (int e = 0; e < 8; ++e) dst[(unsigned)(32 * bj + e) * S] = f2bf(v[bj][e]);
        }
        if (m & 1) asm volatile("" ::: "memory");
      }
    }
    if (gi >= 24 && gi < 32) wave_atomic_max_pos(kmx_run, kmax2 + ((u.pm * 256) >> 13) * 8 + (gi - 24));
  }
};

struct EpiOdIn8 {
  static constexpr bool PERM = true, AFTER_DRAIN = false;
  const float* ssq; const float* gq_norm; const float* gk_norm; const float* cos32; const float* sin32;
  bf16_t* cq; bf16_t* ckv; float* ssq2; float* kpe; bf16_t* qd; bf16_t* kd; bf16_t* vtd; unsigned* kmax2;
  __device__ __forceinline__ void operator()(const pg8::f32x4 (&acc)[2][2][4][2], const pg8::Unit& u, int wr, int wc, int fr, int fq0) const {
    int z; asm volatile("v_mov_b32 %0, 0" : "=v"(z));
    const int fq = fq0 + z;
    const int gi = 4 * u.pn + wc;
    if (gi >= 19) return;
    const int lane = fr + 16 * fq;
    const int row0 = u.pm * 256 + wr * 64 + 4 * fr + z;
    float kmx_run = 0.f;
#pragma unroll
    for (int ai = 0; ai < 2; ++ai) {
      float rs[4];
#pragma unroll
      for (int m = 0; m < 4; ++m) { const f32x4 a = *(const f32x4*)(ssq + (unsigned)(row0 + ai * 128 + m) * 16 + 4 * fq); rs[m] = (a[0] + a[1]) + (a[2] + a[3]); }
#pragma unroll
      for (int m = 0; m < 4; ++m) rs[m] = rsqrtf(grp_sum(rs[m]) * (1.f / 1024.f) + EPS);
      if (gi >= 17) {
        const int tok0 = row0 + ai * 128, bb0 = tok0 >> 13, pos0 = tok0 & (S - 1);
        bf16_t* dst = vtd + ((unsigned)(bb0 * 2 + (gi - 17)) * 64 + 8 * fq) * S + pos0;
#pragma unroll
        for (int bj = 0; bj < 2; ++bj)
#pragma unroll
          for (int n = 0; n < 2; ++n)
#pragma unroll
            for (int c = 0; c < 4; ++c) {
              u32x2 w; w.x = pk2(acc[ai][bj][0][n][c] * rs[0], acc[ai][bj][1][n][c] * rs[1]); w.y = pk2(acc[ai][bj][2][n][c] * rs[2], acc[ai][bj][3][n][c] * rs[3]);
              *(u32x2*)(dst + (unsigned)(32 * bj + 4 * n + c) * S) = w;
            }
        asm volatile("" ::: "memory");
        continue;
      }
#pragma unroll
      for (int m = 0; m < 4; ++m) {
        const int tok = row0 + ai * 128 + m, bb = tok >> 13, pos = tok & (S - 1);
        float v[2][8];
#pragma unroll
        for (int bj = 0; bj < 2; ++bj)
#pragma unroll
          for (int n = 0; n < 2; ++n)
#pragma unroll
            for (int c = 0; c < 4; ++c) v[bj][4 * n + c] = acc[ai][bj][m][n][c] * rs[m];
        if (gi < 6) {
          float ss = 0.f;
#pragma unroll
          for (int bj = 0; bj < 2; ++bj)
#pragma unroll
            for (int e = 0; e < 8; ++e) ss += v[bj][e] * v[bj][e];
          ss = grp_sum(ss);
          if (fq == 0) ssq2[(unsigned)tok * 8 + gi] = ss;
          bf16_t* dst = (gi < 4) ? cq + (unsigned)tok * 256 + gi * 64 + 8 * fq : ckv + (unsigned)tok * 128 + (gi - 4) * 64 + 8 * fq;
          st8_bf16(dst, v[0]); st8_bf16(dst + 32, v[1]);
        } else if (gi == 6) {
          float* dst = kpe + (unsigned)tok * 32 + 8 * fq;
          *(f32x4*)dst = (f32x4){v[0][0], v[0][1], v[0][2], v[0][3]}; *(f32x4*)(dst + 4) = (f32x4){v[0][4], v[0][5], v[0][6], v[0][7]};
        } else if (gi < 17) {
          const bool isq = gi < 15; const float* gn = isq ? gq_norm : gk_norm;
          float ss = 0.f;
#pragma unroll
          for (int bj = 0; bj < 2; ++bj)
#pragma unroll
            for (int e = 0; e < 8; ++e) ss += v[bj][e] * v[bj][e];
          const float rn = rsqrtf(grp_sum(ss) * (1.f / 64.f) + EPS) * (isq ? 0.125f * LOG2E : 1.f);
          float kk = 0.f;
#pragma unroll
          for (int bj = 0; bj < 2; ++bj) {
            const unsigned ao = (unsigned)(bj == 0 ? (pos >> 6) : (pos & 63)) * 16 + 8 * (fq & 1);
            const f32x4 c0 = *(const f32x4*)(cos32 + ao), c1 = *(const f32x4*)(cos32 + ao + 4), s0 = *(const f32x4*)(sin32 + ao), s1 = *(const f32x4*)(sin32 + ao + 4);
#pragma unroll
            for (int e = 0; e < 8; ++e) {
              const float own = v[bj][e] * rn * gn[32 * bj + 8 * fq + e];
              const float oth = lane32_partner(own, lane);
              const float cc = e < 4 ? c0[e & 3] : c1[e & 3], sn = e < 4 ? s0[e & 3] : s1[e & 3];
              v[bj][e] = (fq < 2) ? own * cc - oth * sn : oth * sn + own * cc;
              kk += v[bj][e] * v[bj][e];
            }
          }
          bf16_t* dst = isq ? qd + ((unsigned)(bb * 8 + (gi - 7)) * S + pos) * 64 + 8 * fq : kd + ((unsigned)(bb * 2 + (gi - 15)) * S + pos) * 64 + 8 * fq;
          st8_bf16(dst, v[0]); st8_bf16(dst + 32, v[1]);
          if (!isq) kmx_run = fmaxf(kmx_run, grp_sum(kk));
        } else {
          bf16_t* dst = vtd + ((unsigned)(bb * 2 + (gi - 17)) * 64 + 8 * fq) * S + pos;
#pragma unroll
          for (int bj = 0; bj < 2; ++bj)
#pragma unroll
            for (int e = 0; e < 8; ++e) dst[(unsigned)(32 * bj + e) * S] = f2bf(v[bj][e]);
        }
        if (m & 1) asm volatile("" ::: "memory");
      }
    }
    if (gi == 15 || gi == 16) wave_atomic_max_pos(kmx_run, kmax2 + 32 + ((u.pm * 256) >> 13) * 2 + (gi - 15));
  }
};

template <int DQK, int DV>
__device__ __forceinline__ void attn_pass(const bf16_t* __restrict__ qh, const bf16_t* __restrict__ kh, const bf16_t* __restrict__ vth, int q0, char* smem, f32x16 (&o)[DV / 32], float kmax) {
  constexpr int KP = (DQK + 8) * 2, VP = 144, KSB = 64 * KP, VSB = DV * VP;
  constexpr int CK = DQK / 8, TKC = 64 * CK, NKC = (TKC + 511) / 512, NVC = DV / 64, NKS = DQK / 16, NEB = DV / 32, NT = S / 64;
  char* sK = smem; char* sV = smem + 2 * KSB;
  int tid = threadIdx.x; asm volatile("" : "+v"(tid));
  const int lane = tid & 63, wid = tid >> 6, r = lane & 31, h = lane >> 5;
  bf16x8 qf[NKS];
  {
    const bf16_t* qrow = qh + (size_t)(q0 + 32 * wid + r) * DQK + 8 * h;
#pragma unroll
    for (int ks = 0; ks < NKS; ++ks) qf[ks] = *(const bf16x8*)(qrow + 16 * ks);
  }
  int klo[NKC], vlo[NVC];
  const bf16_t* vg0 = vth + (size_t)(tid >> 3) * S + (tid & 7) * 8;
  const bool k1 = (TKC % 512 == 0) || (tid < TKC % 512);
#pragma unroll
  for (int j = 0; j < NKC; ++j) { const int c = tid + 512 * j; klo[j] = (c / CK) * KP + (c % CK) * 16; }
#pragma unroll
  for (int j = 0; j < NVC; ++j) { const int c = tid + 512 * j; vlo[j] = (c >> 3) * VP + (c & 7) * 16; }
  u32x4 rk[NKC], rv[NVC], rk1[NKC];
  const int rot = (int)((blockIdx.x >> 3) * 4u) & (NT - 1);
#define LOADK(dst, t) do { _Pragma("unroll") for (int j = 0; j < NKC; ++j) if (j == 0 || k1) dst[j] = *(const u32x4*)(kh + (size_t)(((t) + rot) & (NT - 1)) * 64 * DQK + (size_t)(tid + 512 * j) * 8); } while (0)
#define LOADV(dst, t) do { _Pragma("unroll") for (int j = 0; j < NVC; ++j) dst[j] = *(const u32x4*)(vg0 + (size_t)(64 * j) * S + (size_t)(((t) + rot) & (NT - 1)) * 64); } while (0)
#define STOREK(src, slot) do { _Pragma("unroll") for (int j = 0; j < NKC; ++j) if (j == 0 || k1) *(u32x4*)(sK + (slot) * KSB + klo[j]) = src[j]; } while (0)
#define STOREV(src, slot) do { _Pragma("unroll") for (int j = 0; j < NVC; ++j) *(u32x4*)(sV + (slot) * VSB + vlo[j]) = src[j]; } while (0)
  LOADK(rk, 0); LOADV(rv, 0); LOADK(rk1, 1);
#pragma unroll
  for (int eb = 0; eb < NEB; ++eb)
#pragma unroll
    for (int i = 0; i < 16; ++i) o[eb][i] = 0.f;
  float l_run = 0.f;
  f32x16 negm;
  {
    float qq = 0.f;
#pragma unroll
    for (int ks = 0; ks < NKS; ++ks)
#pragma unroll
      for (int j = 0; j < 8; ++j) { const float t = bf2f((unsigned short)qf[ks][j]); qq += t * t; }
    { auto rr = __builtin_amdgcn_permlane32_swap(__float_as_uint(qq), __float_as_uint(qq), false, false); qq = __uint_as_float(rr[0]) + __uint_as_float(rr[1]); }
    const float mref = sqrtf(qq) * kmax * 1.01f + 0.01f;
#pragma unroll
    for (int i = 0; i < 16; ++i) negm[i] = -mref;
  }
  __syncthreads();
  STOREK(rk, 0); STOREV(rv, 0); STOREK(rk1, 1);
  LOADK(rk, 2); LOADV(rv, 1);
  const int kofs = swz23(r) * KP + 16 * h, vofs = r * VP + 16 * h;
  __syncthreads();
  f32x16 sA, sB;
#define QKT(SD, slot) do { const char* kb0_ = sK + (slot) * KSB + kofs; \
    { const bf16x8 a0 = *(const bf16x8*)(kb0_), a1 = *(const bf16x8*)(kb0_ + 32 * KP); SD##0 = MFMA(a0, qf[0], negm); SD##1 = MFMA(a1, qf[0], negm); } \
    _Pragma("unroll") for (int ks = 1; ks < NKS; ++ks) { const bf16x8 a0 = *(const bf16x8*)(kb0_ + ks * 32), a1 = *(const bf16x8*)(kb0_ + 32 * KP + ks * 32); \
      SD##0 = MFMA(a0, qf[ks], SD##0); SD##1 = MFMA(a1, qf[ks], SD##1); } } while (0)
  f32x16 sA0, sA1, sB0, sB1;
  QKT(sA, 0);
#define STEP(SC, SN, t) do { \
    __syncthreads(); \
    if ((t) + 2 < NT) { STOREK(rk, (t) & 1); } \
    if ((t) + 1 < NT) { STOREV(rv, ((t) + 1) & 1); } \
    if ((t) + 3 < NT) { LOADK(rk, (t) + 3); } \
    if ((t) + 2 < NT) { LOADV(rv, (t) + 2); } \
    if ((t) + 1 < NT) { QKT(SN, ((t) + 1) & 1); } \
    float rsum0 = 0.f, rsum1 = 0.f; \
    _Pragma("unroll") for (int i = 0; i < 16; ++i) { SC##0[i] = fexp2(SC##0[i]); SC##1[i] = fexp2(SC##1[i]); rsum0 += SC##0[i]; rsum1 += SC##1[i]; } \
    l_run += rsum0 + rsum1; \
    bf16x8 pf[2][2]; \
    { u32x4 w; \
      w.x = pk2(SC##0[0], SC##0[1]); w.y = pk2(SC##0[2], SC##0[3]); w.z = pk2(SC##0[4], SC##0[5]); w.w = pk2(SC##0[6], SC##0[7]); pf[0][0] = __builtin_bit_cast(bf16x8, w); \
      w.x = pk2(SC##0[8], SC##0[9]); w.y = pk2(SC##0[10], SC##0[11]); w.z = pk2(SC##0[12], SC##0[13]); w.w = pk2(SC##0[14], SC##0[15]); pf[0][1] = __builtin_bit_cast(bf16x8, w); \
      w.x = pk2(SC##1[0], SC##1[1]); w.y = pk2(SC##1[2], SC##1[3]); w.z = pk2(SC##1[4], SC##1[5]); w.w = pk2(SC##1[6], SC##1[7]); pf[1][0] = __builtin_bit_cast(bf16x8, w); \
      w.x = pk2(SC##1[8], SC##1[9]); w.y = pk2(SC##1[10], SC##1[11]); w.z = pk2(SC##1[12], SC##1[13]); w.w = pk2(SC##1[14], SC##1[15]); pf[1][1] = __builtin_bit_cast(bf16x8, w); } \
    const char* vb0_ = sV + ((t) & 1) * VSB + vofs; \
    _Pragma("unroll") for (int kb = 0; kb < 2; ++kb) \
      _Pragma("unroll") for (int s2 = 0; s2 < 2; ++s2) \
        _Pragma("unroll") for (int eb = 0; eb < NEB; ++eb) { \
          const bf16x8 a = *(const bf16x8*)(vb0_ + eb * 32 * VP + (32 * kb + 16 * s2) * 2); \
          o[eb] = MFMA(a, pf[kb][s2], o[eb]); } \
  } while (0)
#pragma unroll
  for (int ks = 0; ks < NKS; ++ks) asm volatile("" :: "v"(qf[ks]));
#pragma unroll 1
  for (int kt = 0; kt < NT; kt += 2) {
    STEP(sA, sB, kt);
    STEP(sB, sA, kt + 1);
  }
#undef STEP
#undef QKT
#undef LOADK
#undef LOADV
#undef STOREK
#undef STOREV
  float ltot;
  { auto rr = __builtin_amdgcn_permlane32_swap(__float_as_uint(l_run), __float_as_uint(l_run), false, false); ltot = __uint_as_float(rr[0]) + __uint_as_float(rr[1]); }
  const float linv = frcp(ltot);
#pragma unroll
  for (int eb = 0; eb < NEB; ++eb)
#pragma unroll
    for (int i = 0; i < 16; ++i) o[eb][i] *= linv;
}

template <int DQK, int DV>
__device__ __forceinline__ void attn_pass2(const bf16_t* __restrict__ qh, const bf16_t* __restrict__ kh, const bf16_t* __restrict__ vth, int q0, char* smem, f32x16 (&o)[2][DV / 32], float kmax) {
  constexpr int KP = (DQK + 8) * 2, VP = 144, KSB = 64 * KP, VSB = DV * VP;
  constexpr int CK = DQK / 8, TKC = 64 * CK, NKC = (TKC + 511) / 512, NVC = DV / 64, NKS = DQK / 16, NEB = DV / 32, NT = S / 64;
  char* sK = smem; char* sV = smem + 2 * KSB;
  int tid = threadIdx.x; asm volatile("" : "+v"(tid));
  const int lane = tid & 63, wid = tid >> 6, r = lane & 31, h = lane >> 5;
  bf16x8 qf[2][NKS];
#pragma unroll
  for (int qb = 0; qb < 2; ++qb) {
    const bf16_t* qrow = qh + (size_t)(q0 + 64 * wid + 32 * qb + r) * DQK + 8 * h;
#pragma unroll
    for (int ks = 0; ks < NKS; ++ks) qf[qb][ks] = *(const bf16x8*)(qrow + 16 * ks);
  }
  int klo[NKC], vlo[NVC];
  const bf16_t* vg0 = vth + (size_t)(tid >> 3) * S + (tid & 7) * 8;
#pragma unroll
  for (int j = 0; j < NKC; ++j) { const int c = tid + 512 * j; klo[j] = (c / CK) * KP + (c % CK) * 16; }
#pragma unroll
  for (int j = 0; j < NVC; ++j) { const int c = tid + 512 * j; vlo[j] = (c >> 3) * VP + (c & 7) * 16; }
  u32x4 rk[NKC], rv[NVC];
  const bool k1 = (TKC % 512 == 0) || (tid < TKC % 512);
#define LOADKV(t) do { \
    _Pragma("unroll") for (int j = 0; j < NKC; ++j) if (j + 1 < NKC || k1) rk[j] = *(const u32x4*)(kh + (size_t)(t) * 64 * DQK + (size_t)(tid + 512 * j) * 8); \
    _Pragma("unroll") for (int j = 0; j < NVC; ++j) rv[j] = *(const u32x4*)(vg0 + (size_t)(64 * j) * S + (size_t)(t) * 64); } while (0)
#define STOREKV(slot) do { \
    _Pragma("unroll") for (int j = 0; j < NKC; ++j) if (j + 1 < NKC || k1) *(u32x4*)(sK + (slot) * KSB + klo[j]) = rk[j]; \
    _Pragma("unroll") for (int j = 0; j < NVC; ++j) *(u32x4*)(sV + (slot) * VSB + vlo[j]) = rv[j]; } while (0)
  LOADKV(0);
#pragma unroll
  for (int qb = 0; qb < 2; ++qb)
#pragma unroll
    for (int eb = 0; eb < NEB; ++eb)
#pragma unroll
      for (int i = 0; i < 16; ++i) o[qb][eb][i] = 0.f;
  float l_run[2] = {0.f, 0.f}, mref[2];
#pragma unroll
  for (int qb = 0; qb < 2; ++qb) {
    float qq = 0.f;
#pragma unroll
    for (int ks = 0; ks < NKS; ++ks)
#pragma unroll
      for (int j = 0; j < 8; ++j) { const float t = bf2f((unsigned short)qf[qb][ks][j]); qq += t * t; }
    { auto rr = __builtin_amdgcn_permlane32_swap(__float_as_uint(qq), __float_as_uint(qq), false, false); qq = __uint_as_float(rr[0]) + __uint_as_float(rr[1]); }
    mref[qb] = sqrtf(qq) * kmax * 1.01f + 0.01f;
  }
  __syncthreads();
  STOREKV(0);
  LOADKV(1);
  const int kofs = swz23(r) * KP + 16 * h, vofs = r * VP + 16 * h;
#pragma unroll
  for (int qb = 0; qb < 2; ++qb)
#pragma unroll
    for (int ks = 0; ks < NKS; ++ks) asm volatile("" :: "v"(qf[qb][ks]));
#pragma unroll 1
  for (int kt = 0; kt < NT; ++kt) {
    const int cur = kt & 1;
    __syncthreads();
    if (kt + 1 < NT) { STOREKV(cur ^ 1); if (kt + 2 < NT) LOADKV(kt + 2); }
    f32x16 s[2][2];
    const char* kb0 = sK + cur * KSB + kofs;
#pragma unroll
    for (int ks = 0; ks < NKS; ++ks) {
      const bf16x8 a0 = *(const bf16x8*)(kb0 + ks * 32), a1 = *(const bf16x8*)(kb0 + 32 * KP + ks * 32);
#pragma unroll
      for (int qb = 0; qb < 2; ++qb) {
        if (ks == 0) {
          f32x16 z;
#pragma unroll
          for (int i = 0; i < 16; ++i) z[i] = 0.f;
          s[qb][0] = MFMA(a0, qf[qb][0], z); s[qb][1] = MFMA(a1, qf[qb][0], z);
        } else { s[qb][0] = MFMA(a0, qf[qb][ks], s[qb][0]); s[qb][1] = MFMA(a1, qf[qb][ks], s[qb][1]); }
      }
    }
    __builtin_amdgcn_sched_barrier(0);
#pragma unroll
    for (int qb = 0; qb < 2; ++qb) {
      float rs0 = 0.f, rs1 = 0.f;
#pragma unroll
      for (int i = 0; i < 16; ++i) { s[qb][0][i] = fexp2(s[qb][0][i] - mref[qb]); s[qb][1][i] = fexp2(s[qb][1][i] - mref[qb]); rs0 += s[qb][0][i]; rs1 += s[qb][1][i]; }
      l_run[qb] += rs0 + rs1;
    }
    const char* vb0 = sV + cur * VSB + vofs;
#pragma unroll
    for (int kb = 0; kb < 2; ++kb)
#pragma unroll
      for (int s2 = 0; s2 < 2; ++s2) {
        bf16x8 pq[2];
#pragma unroll
        for (int qb = 0; qb < 2; ++qb) {
          u32x4 w;
          w.x = pk2(s[qb][kb][8 * s2 + 0], s[qb][kb][8 * s2 + 1]); w.y = pk2(s[qb][kb][8 * s2 + 2], s[qb][kb][8 * s2 + 3]);
          w.z = pk2(s[qb][kb][8 * s2 + 4], s[qb][kb][8 * s2 + 5]); w.w = pk2(s[qb][kb][8 * s2 + 6], s[qb][kb][8 * s2 + 7]);
          pq[qb] = __builtin_bit_cast(bf16x8, w);
        }
#pragma unroll
        for (int eb = 0; eb < NEB; ++eb) {
          const bf16x8 a = *(const bf16x8*)(vb0 + eb * 32 * VP + (32 * kb + 16 * s2) * 2);
#pragma unroll
          for (int qb = 0; qb < 2; ++qb) o[qb][eb] = MFMA(a, pq[qb], o[qb][eb]);
        }
      }
  }
#undef LOADKV
#undef STOREKV
#pragma unroll
  for (int qb = 0; qb < 2; ++qb) {
    float ltot;
    { auto rr = __builtin_amdgcn_permlane32_swap(__float_as_uint(l_run[qb]), __float_as_uint(l_run[qb]), false, false); ltot = __uint_as_float(rr[0]) + __uint_as_float(rr[1]); }
    const float linv = frcp(ltot);
#pragma unroll
    for (int eb = 0; eb < NEB; ++eb)
#pragma unroll
      for (int i = 0; i < 16; ++i) o[qb][eb][i] *= linv;
  }
}

__device__ __forceinline__ void store_o64(bf16_t* dst, const f32x16 (&o)[2], int h) {
#pragma unroll
  for (int eb = 0; eb < 2; ++eb)
#pragma unroll
    for (int i4 = 0; i4 < 4; ++i4) { u32x2 w; w.x = pk2(o[eb][4 * i4], o[eb][4 * i4 + 1]); w.y = pk2(o[eb][4 * i4 + 2], o[eb][4 * i4 + 3]); *(u32x2*)(dst + 32 * eb + 8 * i4 + 4 * h) = w; }
}

__device__ __forceinline__ int srccol(int mapid, int b) {
  if (mapid >= 5) { const int pn = b >> 3, bj = (b >> 2) & 1, wc = b & 3; return srccol(mapid == 5 ? 0 : 2, 2 * (4 * pn + wc) + bj); }
  if (mapid == 0) return 32 * b;
  if (mapid == 1) { const int pn = b >> 3, w = b & 7; return ((w >> 2) ? 2816 : 0) + 128 * pn + 32 * (w & 3); }
  if (mapid == 2) { if (b < 13) return 32 * b; if (b == 13) return -1; if (b < 38) return 416 + 32 * (b - 14); return -1; }
  const int hd = b >> 2, sub = b & 3; return sub < 3 ? hd * 96 + 32 * sub : -1;
}
__device__ __forceinline__ unsigned pk2h(float lo, float hi) { typedef _Float16 h2_t __attribute__((ext_vector_type(2))); const h2_t v = {(_Float16)lo, (_Float16)hi}; return __builtin_bit_cast(unsigned, v); }
template <int KB, bool F16 = false>
__device__ __forceinline__ void conv_matrix(const float* __restrict__ src, int ldsrc, int K, bf16_t* __restrict__ dst, int nblk, int mapid, const float* __restrict__ gain, float* tile, int wb = -1, int wn = 0) {
  if (wb < 0) { wb = blockIdx.x; wn = gridDim.x; }
  const int kblks = K / KB, nunits = (nblk >> 1) * kblks; int tid = threadIdx.x; asm volatile("" : "+v"(tid));
#pragma unroll 1
  for (int u = wb; u < nunits; u += wn) {
    const int nb = u / kblks, kb = u % kblks;
    const int c = tid & 63, kr = tid >> 6;
    const int sc = srccol(mapid, nb * 2 + (c >> 5));
    float v[KB / 8];
    if (sc >= 0) {
      const float* sp = src + (size_t)(kb * KB + kr) * ldsrc + sc + (c & 31);
#pragma unroll
      for (int p = 0; p < KB / 8; ++p) v[p] = sp[(size_t)(p * 8) * ldsrc];
      if (gain) {
#pragma unroll
        for (int p = 0; p < KB / 8; ++p) v[p] *= gain[kb * KB + p * 8 + kr];
      }
    } else {
#pragma unroll
      for (int p = 0; p < KB / 8; ++p) v[p] = 0.f;
    }
    __syncthreads();
#pragma unroll
    for (int p = 0; p < KB / 8; ++p) tile[(p * 8 + kr) * 65 + c] = v[p];
    __syncthreads();
    const int nr = tid >> 3, kc = tid & 7;
#pragma unroll
    for (int q = 0; q < KB / 64; ++q) {
      const float* tp = tile + (q * 64 + kc * 8) * 65 + nr;
      u32x4 w;
      if constexpr (F16) { w.x = pk2h(tp[0], tp[65]); w.y = pk2h(tp[130], tp[195]); w.z = pk2h(tp[260], tp[325]); w.w = pk2h(tp[390], tp[455]); }
      else { w.x = pk2(tp[0], tp[65]); w.y = pk2(tp[130], tp[195]); w.z = pk2(tp[260], tp[325]); w.w = pk2(tp[390], tp[455]); }
      *(u32x4*)(dst + (size_t)(nb * 64 + nr) * K + kb * KB + q * 64 + kc * 8) = w;
    }
  }
}

#define XB_TMO      128
#define XB_XCNT(j)  (256  + 64 * (j))
#define XB_XSUB(j)  (1280 + 64 * (j))
#define XB_XGEN(j)  (2304 + 64 * (j))
#define XB_TOP      3328
#define XB_TOPGEN   3392
#define XCD_BAR_WORDS 3456
#define XB_SPIN_CAP (1u << 18)
#define LAS __attribute__((address_space(3)))
__device__ __forceinline__ unsigned xb_ld(unsigned* p)              { return __hip_atomic_load(p, __ATOMIC_RELAXED, __HIP_MEMORY_SCOPE_AGENT); }
__device__ __forceinline__ unsigned xb_add(unsigned* p, unsigned v) { return __hip_atomic_fetch_add(p, v, __ATOMIC_RELAXED, __HIP_MEMORY_SCOPE_AGENT); }
__device__ __forceinline__ unsigned xb_xcc_id() { return (unsigned)__builtin_amdgcn_s_getreg((3 << 11) | 20) & 0xFu; }
#define XB_SPIN(cond, bar) do { unsigned _sp = 0; while (cond) { __builtin_amdgcn_s_sleep(1); \
    if ((++_sp & 255u) == 0u) { if (xb_ld(&(bar)[XB_TMO])) break; if (_sp > XB_SPIN_CAP) { atomicAdd(&(bar)[XB_TMO], 1u); break; } } } } while (0)
struct XcdBarrier { unsigned* bar; unsigned x; volatile LAS unsigned* st; };
__device__ __forceinline__ XcdBarrier xcd_barrier_post(unsigned* bar, volatile LAS unsigned* st) {
    XcdBarrier b; b.bar = bar; b.x = xb_xcc_id(); b.st = st;
    if (threadIdx.x == 0) (void)xb_add(&bar[XB_XCNT(b.x)], 1u);
    return b;
}
__device__ __forceinline__ void xcd_barrier_complete(unsigned* bar, unsigned x, unsigned& nloc, unsigned& nx) {
    const unsigned G = gridDim.x * gridDim.y * gridDim.z;
    unsigned sum, cnt, mine, sp = 0u;
    for (;;) {
        sum = 0u; cnt = 0u; mine = 0u;
#pragma unroll
        for (unsigned j = 0; j < 16; ++j) { const unsigned c = xb_ld(&bar[XB_XCNT(j)]); sum += c; cnt += (c > 0u) ? 1u : 0u; mine = (j == x) ? c : mine; }
        if (sum == G) break;
        __builtin_amdgcn_s_sleep(1);
        if ((++sp & 255u) == 0u) { if (xb_ld(&bar[XB_TMO])) break; if (sp > XB_SPIN_CAP) { atomicAdd(&bar[XB_TMO], 1u); break; } }
    }
    nloc = mine > 0u ? mine : 1u; nx = cnt > 0u ? cnt : 1u;
}
__device__ __forceinline__ void xcd_barrier(const XcdBarrier& b) {
    asm volatile("s_waitcnt vmcnt(0)" ::: "memory");
    __syncthreads();
    if (threadIdx.x == 0) {
        unsigned* bar = b.bar;
        __builtin_amdgcn_s_waitcnt(0);
        unsigned nloc = b.st[0], nx = b.st[1];
        if (nloc == 0u) { xcd_barrier_complete(bar, b.x, nloc, nx); b.st[0] = nloc; b.st[1] = nx; }
        const unsigned old = xb_add(&bar[XB_XSUB(b.x)], 1u);
        const unsigned gen = old / nloc;
        if (old + 1u == (gen + 1u) * nloc) {
            __builtin_amdgcn_fence(__ATOMIC_RELEASE, "agent");
            asm volatile("s_waitcnt vmcnt(0)" ::: "memory");
            const unsigned og = xb_add(&bar[XB_TOP], 1u);
            const unsigned tg = og / nx;
            if (og + 1u == (tg + 1u) * nx) xb_add(&bar[XB_TOPGEN], 1u);
            else XB_SPIN(xb_ld(&bar[XB_TOPGEN]) == tg, bar);
            __builtin_amdgcn_fence(__ATOMIC_ACQUIRE, "agent");
            xb_add(&bar[XB_XGEN(b.x)], 1u);
            asm volatile("s_waitcnt vmcnt(0)" ::: "memory");
        } else {
            XB_SPIN(xb_ld(&bar[XB_XGEN(b.x)]) == gen, bar);
            __builtin_amdgcn_fence(__ATOMIC_ACQUIRE, "agent");
            asm volatile("s_waitcnt vmcnt(0)" ::: "memory");
        }
    }
    __syncthreads();
}

__global__ void __launch_bounds__(512, 2) mega_fwd(Params p_arg) {
  typedef const __attribute__((address_space(4))) Params* KParamsPtr;
  KParamsPtr pptr = (KParamsPtr)__builtin_amdgcn_kernarg_segment_ptr(); asm volatile("" : "+s"(pptr));
  const __attribute__((address_space(4))) Params& p = *pptr;
  __shared__ __attribute__((aligned(16))) char smem[147456 + 16];
  cg::grid_group grid = cg::this_grid();
  if (p.flags) grid.sync();
  if (threadIdx.x == 0) { *(volatile LAS unsigned*)(smem + 147456) = 0u; *(volatile LAS unsigned*)(smem + 147460) = 0u; }
  __syncthreads();
  const XcdBarrier xbar = xcd_barrier_post((unsigned*)(p.ws + O_CTL), (volatile LAS unsigned*)(smem + 147456));
  char* ws = p.ws;
  float* cos64 = (float*)(ws + O_COS64); float* sin64 = (float*)(ws + O_SIN64);
  float* cos32 = (float*)(ws + O_COS32); float* sin32 = (float*)(ws + O_SIN32);
  float* ssq = (float*)(ws + O_SSQ); float* ssq2 = (float*)(ws + O_SSQ2); float* kpe = (float*)(ws + O_KPE);
  bf16_t* xb = (bf16_t*)(ws + O_XB); bf16_t* hbuf = (bf16_t*)(ws + O_H); bf16_t* mix = (bf16_t*)p.out; _Float16* x16 = (_Float16*)(ws + O_X16);
  const int G = gridDim.x;

  {
    float* tile = (float*)smem;
    const bool defer = (G == 256);
    for (int l = 0; l < (defer ? 1 : 2); ++l) {
      conv_matrix<256, true>(p.ffn1_w_gu + (size_t)l * 1024 * 5632, 5632, 1024, (bf16_t*)(ws + O_WGU + (size_t)(2 * l) * SZ_WGU), 176, 1, p.ffn1_norm + l * 1024, tile);
      conv_matrix<256, true>(p.ffn2_w_gu + (size_t)l * 1024 * 5632, 5632, 1024, (bf16_t*)(ws + O_WGU + (size_t)(2 * l + 1) * SZ_WGU), 176, 1, p.ffn2_norm + l * 1024, tile);
      conv_matrix<256>(p.ffn1_w_down + (size_t)l * 2816 * 1024, 1024, 2816, (bf16_t*)(ws + O_WDN + (size_t)(2 * l) * SZ_WDN), 32, 0, nullptr, tile);
      conv_matrix<256>(p.ffn2_w_down + (size_t)l * 2816 * 1024, 1024, 2816, (bf16_t*)(ws + O_WDN + (size_t)(2 * l + 1) * SZ_WDN), 32, 0, nullptr, tile);
    }
    conv_matrix<256, true>(p.ev_w_in, 2560, 1024, (bf16_t*)(ws + O_WEVIN), 80, 5, p.ev_norm, tile);
    conv_matrix<256>(p.ev_w_out, 1024, 1024, (bf16_t*)(ws + O_WEVOUT), 32, 0, nullptr, tile);
    if (!defer) {
      conv_matrix<256, true>(p.od_w_in, 1184, 1024, (bf16_t*)(ws + O_WODIN), 40, 6, p.od_norm, tile);
      conv_matrix<256>(p.od_w_uq, 768, 256, (bf16_t*)(ws + O_WUQ), 32, 3, p.od_cq_norm, tile);
      conv_matrix<128>(p.od_w_ukv, 1024, 128, (bf16_t*)(ws + O_WUKV), 32, 0, p.od_ckv_norm, tile);
      conv_matrix<256>(p.od_w_out, 1024, 1024, (bf16_t*)(ws + O_WODOUT), 32, 0, nullptr, tile);
    }
    int tid = threadIdx.x; asm volatile("" : "+v"(tid));
    const int lane = tid & 63, wid = tid >> 6;
    const int gt = blockIdx.x * 512 + tid, nth = G * 512;
    { bf16_t* wss = (bf16_t*)(ws + O_WSS);
      for (int i = gt; i < 8 * 128 * 128 / 4; i += nth) { const f32x4 v = *(const f32x4*)(p.ev_w_s + (size_t)i * 4); u32x2 w; w.x = pk2(v[0], v[1]); w.y = pk2(v[2], v[3]); *(u32x2*)(wss + (size_t)i * 4) = w; } }
    for (int i = gt; i < 8192 * 32; i += nth) {
      const int pp = i >> 5, d = i & 31; const float inv = (float)exp2(-(double)d * (13.287712379549449 / 32.0)); const float ang = (float)pp * inv;
      cos64[i] = (float)cos((double)ang); sin64[i] = (float)sin((double)ang);
    }
    for (int i = gt; i < 8192 * 16; i += nth) {
      const int pp = i >> 4, d = i & 15; const float inv = (float)exp2(-(double)d * (13.287712379549449 / 16.0)); const float ang = (float)pp * inv;
      cos32[i] = (float)cos((double)ang); sin32[i] = (float)sin((double)ang);
    }
    for (int row = blockIdx.x * 8 + wid; row < T; row += G * 8) {
      const float* xr = p.x + (size_t)row * DM + lane * 16; float ss = 0.f; u32x4 w0, w1;
      const f32x4 a = *(const f32x4*)(xr), b = *(const f32x4*)(xr + 4), c = *(const f32x4*)(xr + 8), d = *(const f32x4*)(xr + 12);
      ss = (a[0] * a[0] + a[1] * a[1] + a[2] * a[2] + a[3] * a[3]) + (b[0] * b[0] + b[1] * b[1] + b[2] * b[2] + b[3] * b[3]) + (c[0] * c[0] + c[1] * c[1] + c[2] * c[2] + c[3] * c[3]) + (d[0] * d[0] + d[1] * d[1] + d[2] * d[2] + d[3] * d[3]);
      w0.x = pk2(a[0], a[1]); w0.y = pk2(a[2], a[3]); w0.z = pk2(b[0], b[1]); w0.w = pk2(b[2], b[3]);
      w1.x = pk2(c[0], c[1]); w1.y = pk2(c[2], c[3]); w1.z = pk2(d[0], d[1]); w1.w = pk2(d[2], d[3]);
      { typedef _Float16 h8_t __attribute__((ext_vector_type(8))); typedef float f8_t __attribute__((ext_vector_type(8)));
        const f8_t f0 = {a[0], a[1], a[2], a[3], b[0], b[1], b[2], b[3]}, f1 = {c[0], c[1], c[2], c[3], d[0], d[1], d[2], d[3]};
        *(h8_t*)(x16 + (size_t)row * DM + lane * 16) = __builtin_convertvector(f0, h8_t); *(h8_t*)(x16 + (size_t)row * DM + lane * 16 + 8) = __builtin_convertvector(f1, h8_t); }
      ss += __shfl_xor(ss, 1); ss += __shfl_xor(ss, 2);
      if ((lane & 3) == 0) ssq[(size_t)row * 16 + (lane >> 2)] = ss;
    }
  }
  xcd_barrier(xbar);

  auto layer_body = [&](auto LC) __attribute__((always_inline)) {
    constexpr int l = decltype(LC)::value;
    { pg8::Gemm g{(const bf16_t*)x16, (const bf16_t*)(ws + O_WGU + (size_t)(2 * l) * SZ_WGU), T, 5632, 1024}; pg8::StaticOrder so; so.init(T, 5632, (int)gridDim.x, (int)blockIdx.x); EpiGU8 e{ssq, hbuf};
      pg8::gemm_phase<EpiGU8, pg8::StaticOrder, true, true, true>((PG8_LAS unsigned char*)smem, g, so, e); }
    if constexpr (l == 0) {
      if (G == 256 && blockIdx.x >= 128) {
        float* tile = (float*)smem; const int wb = (int)blockIdx.x - 128;
        conv_matrix<256, true>(p.ffn1_w_gu + (size_t)1024 * 5632, 5632, 1024, (bf16_t*)(ws + O_WGU + (size_t)2 * SZ_WGU), 176, 1, p.ffn1_norm + 1024, tile, wb, 128);
        conv_matrix<256>(p.ffn1_w_down + (size_t)2816 * 1024, 1024, 2816, (bf16_t*)(ws + O_WDN + (size_t)2 * SZ_WDN), 32, 0, nullptr, tile, wb, 128);
        conv_matrix<256, true>(p.od_w_in, 1184, 1024, (bf16_t*)(ws + O_WODIN), 40, 6, p.od_norm, tile, wb, 128);
        conv_matrix<256>(p.od_w_uq, 768, 256, (bf16_t*)(ws + O_WUQ), 32, 3, p.od_cq_norm, tile, wb, 128);
        conv_matrix<128>(p.od_w_ukv, 1024, 128, (bf16_t*)(ws + O_WUKV), 32, 0, p.od_ckv_norm, tile, wb, 128);
      }
    }
    xcd_barrier(xbar);
    { pg8::Gemm g{hbuf, (const bf16_t*)(ws + O_WDN + (size_t)(2 * l) * SZ_WDN), T, 1024, 2816}; pg8::StaticOrder so; so.init(T, 1024, (int)gridDim.x, (int)blockIdx.x); EpiRes8 e{x16, p.out, xb, ssq, 0.5f, 1};
      pg8::gemm_phase<EpiRes8, pg8::StaticOrder, false, true>((PG8_LAS unsigned char*)smem, g, so, e); }
    xcd_barrier(xbar);
    if constexpr (l == 0) {
      bf16_t* ub = (bf16_t*)(ws + O_U); bf16_t* vt = (bf16_t*)(ws + O_VT); bf16_t* qb = (bf16_t*)(ws + O_QB); bf16_t* kb = (bf16_t*)(ws + O_KB); bf16_t* vtb = (bf16_t*)(ws + O_VTB);
      { pg8::Gemm g{(const bf16_t*)x16, (const bf16_t*)(ws + O_WEVIN), T, 2560, 1024}; pg8::StaticOrder so; so.init(T, 2560, (int)gridDim.x, (int)blockIdx.x);
        EpiEvIn8 e{ssq, p.ev_sgu_norm, p.ev_q_norm, p.ev_k_norm, cos64, sin64, ub, vt, qb, kb, vtb, (unsigned*)(ws + O_KMAX)};
        pg8::gemm_phase<EpiEvIn8, pg8::StaticOrder, true, true, true>((PG8_LAS unsigned char*)smem, g, so, e); }
      xcd_barrier(xbar);
      { EpiGmlp e{p.ev_b_s, ub, mix}; gemm_phase<false, 1>((const bf16_t*)(ws + O_WSS), 128, 1, vt, 128, 128, smem, e); }
      {
        float d1 = 0.f, d2 = 0.f;
        for (int i = 0; i < 64; ++i) { d1 += p.ev_lam_q1[i] * p.ev_lam_k1[i]; d2 += p.ev_lam_q2[i] * p.ev_lam_k2[i]; }
        const float lam_init = 0.2f, lam = expf(d1) - expf(d2) + lam_init;
        int tid = threadIdx.x; asm volatile("" : "+v"(tid));
        const int lane = tid & 63, wid = tid >> 6, r = lane & 31, h = lane >> 5;
        const unsigned* kmx = (const unsigned*)(ws + O_KMAX);
#pragma unroll 1
        for (int u = blockIdx.x; u < 256; u += G) {
          const int bh = u & 7, qt = u >> 3, bb = bh >> 2, hd = bh & 3;
          const bf16_t* vth = vtb + (size_t)(bb * 4 + hd) * 128 * S;
          f32x16 o[4];
          const int tok = bb * S + qt * 256 + 32 * wid + r;
          bf16_t* dst = mix + (size_t)tok * DM + 512 + hd * 128;
          attn_pass<64, 128>(qb + (size_t)(bb * 8 + hd * 2) * S * 64, kb + (size_t)(bb * 8 + hd * 2) * S * 64, vth, qt * 256, smem, o, kmax_of(kmx, bb * 8 + hd * 2));
#pragma unroll
          for (int eb = 0; eb < 4; ++eb)
#pragma unroll
            for (int i4 = 0; i4 < 4; ++i4) { u32x2 w; w.x = pk2(o[eb][4 * i4], o[eb][4 * i4 + 1]); w.y = pk2(o[eb][4 * i4 + 2], o[eb][4 * i4 + 3]); *(u32x2*)(dst + 32 * eb + 8 * i4 + 4 * h) = w; }
          attn_pass<64, 128>(qb + (size_t)(bb * 8 + hd * 2 + 1) * S * 64, kb + (size_t)(bb * 8 + hd * 2 + 1) * S * 64, vth, qt * 256, smem, o, kmax_of(kmx, bb * 8 + hd * 2 + 1));
          float ss = 0.f;
#pragma unroll
          for (int eb = 0; eb < 4; ++eb)
#pragma unroll
            for (int i4 = 0; i4 < 4; ++i4) {
              const u32x2 w = *(const volatile u32x2*)(dst + 32 * eb + 8 * i4 + 4 * h);
              const float a0 = __builtin_bit_cast(float, w.x << 16), a1 = __builtin_bit_cast(float, w.x & 0xffff0000u);
              const float a2 = __builtin_bit_cast(float, w.y << 16), a3 = __builtin_bit_cast(float, w.y & 0xffff0000u);
              o[eb][4 * i4] = a0 - lam * o[eb][4 * i4]; o[eb][4 * i4 + 1] = a1 - lam * o[eb][4 * i4 + 1];
              o[eb][4 * i4 + 2] = a2 - lam * o[eb][4 * i4 + 2]; o[eb][4 * i4 + 3] = a3 - lam * o[eb][4 * i4 + 3];
              ss += (o[eb][4 * i4] * o[eb][4 * i4] + o[eb][4 * i4 + 1] * o[eb][4 * i4 + 1]) + (o[eb][4 * i4 + 2] * o[eb][4 * i4 + 2] + o[eb][4 * i4 + 3] * o[eb][4 * i4 + 3]);
            }
          ss += __shfl_xor(ss, 32);
          const float rn = rsqrtf(ss * (1.f / 128.f) + EPS) * (1.f - lam_init);
#pragma unroll
          for (int eb = 0; eb < 4; ++eb)
#pragma unroll
            for (int i4 = 0; i4 < 4; ++i4) {
              float v[4];
#pragma unroll
              for (int c = 0; c < 4; ++c) v[c] = o[eb][4 * i4 + c] * rn * p.ev_sub_norm[32 * eb + 8 * i4 + 4 * h + c];
              u32x2 w; w.x = pk2(v[0], v[1]); w.y = pk2(v[2], v[3]);
              *(u32x2*)(dst + 32 * eb + 8 * i4 + 4 * h) = w;
            }
        }
      }
      xcd_barrier(xbar);
      { pg8::Gemm g{mix, (const bf16_t*)(ws + O_WEVOUT), T, 1024, 1024}; pg8::StaticOrder so; so.init(T, 1024, (int)gridDim.x, (int)blockIdx.x); EpiRes8 e{x16, p.out, xb, ssq, 1.0f, 1};
        pg8::gemm_phase<EpiRes8, pg8::StaticOrder, false, true>((PG8_LAS unsigned char*)smem, g, so, e); }
      xcd_barrier(xbar);
    } else {
      bf16_t* cq = (bf16_t*)(ws + O_CQ); bf16_t* ckv = (bf16_t*)(ws + O_CKV); bf16_t* qc = (bf16_t*)(ws + O_QC); bf16_t* kc = (bf16_t*)(ws + O_KC);
      bf16_t* vtc = (bf16_t*)(ws + O_VTC); bf16_t* qd = (bf16_t*)(ws + O_QD); bf16_t* kd = (bf16_t*)(ws + O_KD); bf16_t* vtd = (bf16_t*)(ws + O_VTD);
      { pg8::Gemm g{(const bf16_t*)x16, (const bf16_t*)(ws + O_WODIN), T, 1280, 1024}; pg8::StaticOrder so; so.init(T, 1280, (int)gridDim.x, (int)blockIdx.x);
        EpiOdIn8 e{ssq, p.od_gqa_q_norm, p.od_gqa_k_norm, cos32, sin32, cq, ckv, ssq2, kpe, qd, kd, vtd, (unsigned*)(ws + O_KMAX)};
        pg8::gemm_phase<EpiOdIn8, pg8::StaticOrder, true, true, true, true>((PG8_LAS unsigned char*)smem, g, so, e); }
      xcd_barrier(xbar);
      { EpiUq e{ssq2, p.od_mla_q_norm, cos32, sin32, qc}; gemm_phase<true, 0>((const bf16_t*)(ws + O_WUQ), 256, 4, cq, 256, 256, smem, e); }
      { EpiUkv e{ssq2, p.od_mla_k_norm, kpe, cos32, sin32, kc, vtc, (unsigned*)(ws + O_KMAX)}; gemm_phase<false, 0>((const bf16_t*)(ws + O_WUKV), 128, 4, ckv, 128, 128, smem, e); }
      xcd_barrier(xbar);
      {
        int tid = threadIdx.x; asm volatile("" : "+v"(tid));
        const int lane = tid & 63, wid = tid >> 6, r = lane & 31, h = lane >> 5;
        const unsigned* kmx = (const unsigned*)(ws + O_KMAX);
#pragma unroll 1
        for (int u = blockIdx.x; u < 512; u += G) {
          if (u < 256) {
            f32x16 o2[2][2];
            const int bh = u & 15, qt = u >> 4, bb = bh >> 3, hh = bh & 7;
            attn_pass2<96, 64>(qc + (size_t)(bb * 8 + hh) * S * 96, kc + (size_t)(bb * 8 + hh) * S * 96, vtc + (size_t)(bb * 8 + hh) * 64 * S, qt * 512, smem, o2, kmax_of(kmx, 16 + bb * 8 + hh));
#pragma unroll
            for (int qb = 0; qb < 2; ++qb) {
              const int tok = bb * S + qt * 512 + 64 * wid + 32 * qb + r;
              store_o64(mix + (size_t)tok * DM + hh * 64, o2[qb], h);
            }
          } else {
            f32x16 o2[2][2];
            const int uu = u - 256, bh = uu & 15, qt = uu >> 4, bb = bh >> 3, hh = bh & 7, kvh = hh >> 2;
            attn_pass2<64, 64>(qd + (size_t)(bb * 8 + hh) * S * 64, kd + (size_t)(bb * 2 + kvh) * S * 64, vtd + (size_t)(bb * 2 + kvh) * 64 * S, qt * 512, smem, o2, kmax_of(kmx, 32 + bb * 2 + kvh));
#pragma unroll
            for (int qb = 0; qb < 2; ++qb) {
              const int tok = bb * S + qt * 512 + 64 * wid + 32 * qb + r;
              store_o64(mix + (size_t)tok * DM + 512 + hh * 64, o2[qb], h);
            }
          }
        }
      }
      xcd_barrier(xbar);
      { pg8::Gemm g{mix, (const bf16_t*)(ws + O_WODOUT), T, 1024, 1024}; pg8::StaticOrder so; so.init(T, 1024, (int)gridDim.x, (int)blockIdx.x); EpiRes8 e{x16, p.out, xb, ssq, 1.0f, 1};
        pg8::gemm_phase<EpiRes8, pg8::StaticOrder, false, true>((PG8_LAS unsigned char*)smem, g, so, e); }
      xcd_barrier(xbar);
    }
    { pg8::Gemm g{(const bf16_t*)x16, (const bf16_t*)(ws + O_WGU + (size_t)(2 * l + 1) * SZ_WGU), T, 5632, 1024}; pg8::StaticOrder so; so.init(T, 5632, (int)gridDim.x, (int)blockIdx.x); EpiGU8 e{ssq, hbuf};
      pg8::gemm_phase<EpiGU8, pg8::StaticOrder, true, true, true>((PG8_LAS unsigned char*)smem, g, so, e); }
    if constexpr (l == 0) {
      if (G == 256 && blockIdx.x >= 128) {
        float* tile = (float*)smem; const int wb = (int)blockIdx.x - 128;
        conv_matrix<256, true>(p.ffn2_w_gu + (size_t)1024 * 5632, 5632, 1024, (bf16_t*)(ws + O_WGU + (size_t)3 * SZ_WGU), 176, 1, p.ffn2_norm + 1024, tile, wb, 128);
        conv_matrix<256>(p.ffn2_w_down + (size_t)2816 * 1024, 1024, 2816, (bf16_t*)(ws + O_WDN + (size_t)3 * SZ_WDN), 32, 0, nullptr, tile, wb, 128);
        conv_matrix<256>(p.od_w_out, 1024, 1024, (bf16_t*)(ws + O_WODOUT), 32, 0, nullptr, tile, wb, 128);
      }
    }
    xcd_barrier(xbar);
    { pg8::Gemm g{hbuf, (const bf16_t*)(ws + O_WDN + (size_t)(2 * l + 1) * SZ_WDN), T, 1024, 2816}; pg8::StaticOrder so; so.init(T, 1024, (int)gridDim.x, (int)blockIdx.x); EpiRes8 e{x16, p.out, xb, ssq, 0.5f, l == 0 ? 1 : 0};
      pg8::gemm_phase<EpiRes8, pg8::StaticOrder, false, true>((PG8_LAS unsigned char*)smem, g, so, e); }
    if (l == 0) xcd_barrier(xbar);
  };
  layer_body(std::integral_constant<int, 0>{});
  layer_body(std::integral_constant<int, 1>{});
}

extern "C" void kernel_launch(void* const* d_in, const int* in_sizes, int n_in, void* d_out, int out_size, void* d_ws, size_t ws_size, hipStream_t stream) {
  static int grid_blocks = 0;
  if (!grid_blocks) {
    int dev = 0, cus = 0, per_cu = 0;
    hipGetDevice(&dev);
    hipDeviceGetAttribute(&cus, hipDeviceAttributeMultiprocessorCount, dev);
    hipOccupancyMaxActiveBlocksPerMultiprocessor(&per_cu, mega_fwd, 512, 0);
    if (per_cu > 1) per_cu = 1;
    if (per_cu < 1) per_cu = 1;
    grid_blocks = cus * per_cu;
  }
  Params p{};
  const float** pp = (const float**)&p;
  for (int i = 0; i < 31; ++i) pp[i] = (const float*)d_in[i];
  p.out = (float*)d_out; p.ws = (char*)d_ws;
  hipMemsetAsync(d_ws, 0, 16384, stream);
  void* args[] = {&p};
  hipError_t e = hipLaunchCooperativeKernel((void*)mega_fwd, dim3(grid_blocks), dim3(512), args, 0, stream);
  if (e != hipSuccess) fprintf(stderr, "cooperative launch failed: %s (grid %d)\n", hipGetErrorString(e), grid_blocks);
}
```
